# Optimizing an MI355X kernel written in HIP

```python
import math
import jax, jax.numpy as jnp
from jax import lax
import numpy as np

D_MODEL = 4096
BATCH = 4
SEQ = 2048
DEPTH = 2

A_HEADS = 16
A_KV_HEADS = 4
A_HEAD_DIM = 128
IDX_HEADS = 16
IDX_DIM = 64
IDX_TOPK_MAX = 256
B_HEADS = 16
B_Q_LORA = 1024
B_KV_LORA = 512
B_NOPE_DIM = 128
B_ROPE_DIM = 64
B_V_DIM = 128
ROPE_THETA = 10000.0
Q_BLOCK = 128
MIX_WIDTH = A_HEADS * A_HEAD_DIM + B_HEADS * B_V_DIM
ATTN_IN_SIZES = (
    A_HEADS * A_HEAD_DIM,
    A_KV_HEADS * A_HEAD_DIM,
    A_KV_HEADS * A_HEAD_DIM,
    IDX_HEADS * IDX_DIM,
    IDX_DIM,
    IDX_HEADS,
    B_Q_LORA,
    B_KV_LORA,
    B_ROPE_DIM,
)
ATTN_IN_WIDTH = sum(ATTN_IN_SIZES)

S5_WIDTH = D_MODEL // 2
S5_GROUP_CH = 16
S5_GROUPS = S5_WIDTH // S5_GROUP_CH
S5_STATE = 64
DT_MIN = 0.001
DT_MAX = 0.1

MOE_GROUPS = 4
MOE_EXPERTS_PER_GROUP = 8
MOE_EXPERTS = MOE_GROUPS * MOE_EXPERTS_PER_GROUP
MOE_FF = 512
MOE_GROUP_TOPK = 1
MOE_TOPK = 2
MOE_BLOCK = 128

RMS_EPS = 1e-6

kernel_name = 'hybrid_dsa_mla_s5_hmoe'


def _rmsnorm(x, g):
    xf = x.astype(jnp.float32)
    y = xf * lax.rsqrt(jnp.mean(xf * xf, axis=-1, keepdims=True) + RMS_EPS)
    return (y * g.astype(jnp.float32)).astype(x.dtype)


def _split_last(t, sizes):
    parts = []
    off = 0
    for s in sizes:
        parts.append(t[..., off:off + s])
        off += s
    return parts


def _rope(t, positions):
    half = t.shape[-1] // 2
    inv = 1.0 / (ROPE_THETA ** (jnp.arange(half, dtype=jnp.float32) / half))
    ang = positions.astype(jnp.float32)[:, :, None] * inv
    cos = jnp.cos(ang)[:, :, None, :]
    sin = jnp.sin(ang)[:, :, None, :]
    tf = t.astype(jnp.float32)
    t1, t2 = tf[..., :half], tf[..., half:]
    out = jnp.concatenate([t1 * cos - t2 * sin, t2 * cos + t1 * sin], axis=-1)
    return out.astype(t.dtype)


def _dsa_attention(q, k, v, iq, ik, iw):
    bsz, seq = q.shape[0], q.shape[1]
    n_sel = min(IDX_TOPK_MAX, seq // 4)
    group = A_HEADS // A_KV_HEADS
    scale = A_HEAD_DIM ** -0.5
    idx_scale = (IDX_DIM ** -0.5) * (IDX_HEADS ** -0.5)
    ikf = ik.astype(jnp.float32)
    key_pos = jnp.arange(seq)
    gather = jax.vmap(lambda t, i: t[i])

    def block(start):
        qpos = start + jnp.arange(Q_BLOCK)
        qb = lax.dynamic_slice_in_dim(q, start, Q_BLOCK, axis=1)
        iqb = lax.dynamic_slice_in_dim(iq, start, Q_BLOCK, axis=1).astype(jnp.float32)
        iwb = lax.dynamic_slice_in_dim(iw, start, Q_BLOCK, axis=1).astype(jnp.float32)
        rel = jax.nn.relu(jnp.einsum('bqhd,bsd->bqhs', iqb, ikf))
        score = jnp.einsum('bqhs,bqh->bqs', rel, iwb) * idx_scale
        causal = key_pos[None, :] <= qpos[:, None]
        score = jnp.where(causal[None], score, -jnp.inf)
        _, sel = lax.top_k(score, n_sel)
        valid = sel <= qpos[None, :, None]
        ks = gather(k, sel)
        vs = gather(v, sel)
        qg = qb.reshape(bsz, Q_BLOCK, A_KV_HEADS, group, A_HEAD_DIM)
        s = jnp.einsum('bqgrd,bqkgd->bqgrk', qg, ks).astype(jnp.float32) * scale
        s = jnp.where(valid[:, :, None, None, :], s, -jnp.inf)
        p = jax.nn.softmax(s, axis=-1).astype(v.dtype)
        o = jnp.einsum('bqgrk,bqkgd->bqgrd', p, vs)
        return o.reshape(bsz, Q_BLOCK, A_HEADS * A_HEAD_DIM)

    starts = jnp.arange(seq // Q_BLOCK) * Q_BLOCK
    out = lax.map(block, starts)
    return jnp.moveaxis(out, 0, 1).reshape(bsz, seq, A_HEADS * A_HEAD_DIM)


def _mla_attention(qn, qr, kn, kr, v):
    bsz, seq = qn.shape[0], qn.shape[1]
    scale = (B_NOPE_DIM + B_ROPE_DIM) ** -0.5
    key_pos = jnp.arange(seq)

    def block(start):
        qpos = start + jnp.arange(Q_BLOCK)
        qnb = lax.dynamic_slice_in_dim(qn, start, Q_BLOCK, axis=1)
        qrb = lax.dynamic_slice_in_dim(qr, start, Q_BLOCK, axis=1)
        s = jnp.einsum('bqhd,bshd->bhqs', qnb, kn) + jnp.einsum('bqhr,bsr->bhqs', qrb, kr)
        s = s.astype(jnp.float32) * scale
        causal = key_pos[None, :] <= qpos[:, None]
        s = jnp.where(causal[None, None], s, -jnp.inf)
        p = jax.nn.softmax(s, axis=-1).astype(v.dtype)
        o = jnp.einsum('bhqs,bshd->bqhd', p, v)
        return o.reshape(bsz, Q_BLOCK, B_HEADS * B_V_DIM)

    starts = jnp.arange(seq // Q_BLOCK) * Q_BLOCK
    out = lax.map(block, starts)
    return jnp.moveaxis(out, 0, 1).reshape(bsz, seq, B_HEADS * B_V_DIM)


def _attention_layer(h, positions, w_in, q_norm, kv_norm, w_uq, w_ukv, w_out):
    bsz, seq, _ = h.shape
    proj = h @ w_in
    qa, ka, va, iq, ik, iw, cq, ckv, kr = _split_last(proj, ATTN_IN_SIZES)
    qa = qa.reshape(bsz, seq, A_HEADS, A_HEAD_DIM)
    ka = ka.reshape(bsz, seq, A_KV_HEADS, A_HEAD_DIM)
    va = va.reshape(bsz, seq, A_KV_HEADS, A_HEAD_DIM)
    iq = iq.reshape(bsz, seq, IDX_HEADS, IDX_DIM)
    out_a = _dsa_attention(qa, ka, va, iq, ik, iw)
    q = (_rmsnorm(cq, q_norm) @ w_uq).reshape(bsz, seq, B_HEADS, B_NOPE_DIM + B_ROPE_DIM)
    qn = q[..., :B_NOPE_DIM]
    qr = _rope(q[..., B_NOPE_DIM:], positions)
    kv = (_rmsnorm(ckv, kv_norm) @ w_ukv).reshape(bsz, seq, B_HEADS, B_NOPE_DIM + B_V_DIM)
    kn = kv[..., :B_NOPE_DIM]
    vb = kv[..., B_NOPE_DIM:]
    kr = _rope(kr[:, :, None, :], positions)[:, :, 0, :]
    out_b = _mla_attention(qn, qr, kn, kr, vb)
    return jnp.concatenate([out_a, out_b], axis=-1) @ w_out


def _ssm_combine(left, right):
    ar1, ai1, br1, bi1 = left
    ar2, ai2, br2, bi2 = right
    ar = ar2 * ar1 - ai2 * ai1
    ai = ar2 * ai1 + ai2 * ar1
    br = ar2 * br1 - ai2 * bi1 + br2
    bi = ar2 * bi1 + ai2 * br1 + bi2
    return (ar, ai, br, bi)


def _s5_layer(h, w_in, lam_re, lam_im, log_dt, b_re, b_im, c_re, c_im, d_skip, w_glu):
    bsz, seq, _ = h.shape
    f32 = jnp.float32
    u = (h @ w_in).astype(f32).reshape(bsz, seq, S5_GROUPS, S5_GROUP_CH)
    lr = lam_re.astype(f32)
    li = lam_im.astype(f32)
    dt = jnp.exp(log_dt.astype(f32))[:, None]
    mag = jnp.exp(lr * dt)
    ang = li * dt
    abar_re = mag * jnp.cos(ang)
    abar_im = mag * jnp.sin(ang)
    den = lr * lr + li * li
    nr = abar_re - 1.0
    f_re = (nr * lr + abar_im * li) / den
    f_im = (abar_im * lr - nr * li) / den
    br = b_re.astype(f32)
    bim = b_im.astype(f32)
    bb_re = f_re[..., None] * br - f_im[..., None] * bim
    bb_im = f_re[..., None] * bim + f_im[..., None] * br
    bu_re = jnp.einsum('gpc,bsgc->bsgp', bb_re, u)
    bu_im = jnp.einsum('gpc,bsgc->bsgp', bb_im, u)
    a_re = jnp.broadcast_to(abar_re, (1, seq, S5_GROUPS, S5_STATE))
    a_im = jnp.broadcast_to(abar_im, (1, seq, S5_GROUPS, S5_STATE))
    _, _, s_re, s_im = lax.associative_scan(_ssm_combine, (a_re, a_im, bu_re, bu_im), axis=1)
    y = (jnp.einsum('gcp,bsgp->bsgc', c_re.astype(f32), s_re)
         - jnp.einsum('gcp,bsgp->bsgc', c_im.astype(f32), s_im)
         + d_skip.astype(f32).reshape(S5_GROUPS, S5_GROUP_CH) * u)
    y = jax.nn.gelu(y.reshape(bsz, seq, S5_WIDTH)).astype(h.dtype)
    val, gate = jnp.split(y @ w_glu, 2, axis=-1)
    return val * jax.nn.sigmoid(gate)


def _hier_moe(h, w_group, b_group, w_expert, b_expert, w_gate_up, w_down):
    bsz, seq, dm = h.shape
    f32 = jnp.float32
    n_tok = bsz * seq
    xf = h.reshape(n_tok, dm)
    g_logit = (xf @ w_group).astype(f32) + b_group.astype(f32)
    g_prob = jax.nn.softmax(g_logit, axis=-1)
    g_gate, g_sel = lax.top_k(g_prob, MOE_GROUP_TOPK)
    e_logit = ((xf @ w_expert).astype(f32) + b_expert.astype(f32)).reshape(
        n_tok, MOE_GROUPS, MOE_EXPERTS_PER_GROUP)
    e_logit = jnp.take_along_axis(e_logit, g_sel[:, :, None], axis=1)[:, 0]
    e_prob = jax.nn.softmax(e_logit, axis=-1)
    e_val, e_sel = lax.top_k(e_prob, MOE_TOPK)
    weight = g_gate * e_val / jnp.sum(e_val, axis=-1, keepdims=True)
    expert_id = g_sel * MOE_EXPERTS_PER_GROUP + e_sel
    n_rows = n_tok * MOE_TOPK
    eid = expert_id.reshape(n_rows).astype(jnp.int32)
    tok = jnp.repeat(jnp.arange(n_tok, dtype=jnp.int32), MOE_TOPK)
    wts = weight.reshape(n_rows)
    order = jnp.argsort(eid)
    eid_s = eid[order]
    tok_s = tok[order]
    w_s = wts[order]
    counts = jnp.bincount(eid, length=MOE_EXPERTS).astype(jnp.int32)
    start = jnp.cumsum(counts) - counts
    padded = (counts + MOE_BLOCK - 1) // MOE_BLOCK * MOE_BLOCK
    pend = jnp.cumsum(padded)
    pstart = pend - padded
    dest = pstart[eid_s] + (jnp.arange(n_rows, dtype=jnp.int32) - start[eid_s])
    n_blocks = -(-n_rows // MOE_BLOCK) + MOE_EXPERTS
    n_slots = n_blocks * MOE_BLOCK
    slot_tok = jnp.full((n_slots,), n_tok, jnp.int32).at[dest].set(tok_s)
    slot_w = jnp.zeros((n_slots,), f32).at[dest].set(w_s)
    block_start = jnp.arange(n_blocks, dtype=jnp.int32) * MOE_BLOCK
    block_expert = jnp.minimum(jnp.searchsorted(pend, block_start, side='right'), MOE_EXPERTS - 1)
    x_pad = jnp.concatenate([xf, jnp.zeros((1, dm), xf.dtype)], axis=0)
    xs = x_pad[slot_tok].reshape(n_blocks, MOE_BLOCK, dm)

    def expert_block(args):
        xb, e = args
        gate, up = jnp.split(xb @ w_gate_up[e], 2, axis=-1)
        return (jax.nn.silu(gate) * up) @ w_down[e]

    ys = lax.map(expert_block, (xs, block_expert)).reshape(n_slots, dm)
    ys = ys * slot_w[:, None].astype(ys.dtype)
    out = jax.ops.segment_sum(ys, slot_tok, num_segments=n_tok + 1)[:n_tok]
    return out.reshape(bsz, seq, dm)


def setup_inputs(seed: int = 0) -> dict:
    key = jax.random.key(seed)
    ks = list(jax.random.split(key, 32))
    f32 = jnp.float32
    n_even = (DEPTH + 1) // 2
    n_odd = DEPTH // 2

    def nrm(k, shape, scale):
        return jax.random.normal(k, shape, f32) * scale

    def gain(k, shape):
        return 1.0 + 0.02 * jax.random.normal(k, shape, f32)

    x = jax.random.normal(ks[0], (BATCH, SEQ, D_MODEL), f32)
    positions = jnp.tile(jnp.arange(SEQ, dtype=jnp.int32)[None, :], (BATCH, 1))
    norm_mix = gain(ks[1], (DEPTH, D_MODEL))
    norm_ffn = gain(ks[2], (DEPTH, D_MODEL))
    norm_final = gain(ks[3], (D_MODEL,))
    attn_w_in = nrm(ks[4], (n_even, D_MODEL, ATTN_IN_WIDTH), D_MODEL ** -0.5)
    attn_q_norm = gain(ks[5], (n_even, B_Q_LORA))
    attn_kv_norm = gain(ks[6], (n_even, B_KV_LORA))
    attn_w_uq = nrm(ks[7], (n_even, B_Q_LORA, B_HEADS * (B_NOPE_DIM + B_ROPE_DIM)), B_Q_LORA ** -0.5)
    attn_w_ukv = nrm(ks[8], (n_even, B_KV_LORA, B_HEADS * (B_NOPE_DIM + B_V_DIM)), B_KV_LORA ** -0.5)
    attn_w_out = nrm(ks[9], (n_even, MIX_WIDTH, D_MODEL), MIX_WIDTH ** -0.5)
    ssm_w_in = nrm(ks[10], (n_odd, D_MODEL, S5_WIDTH), D_MODEL ** -0.5)
    ssm_lam_re = -0.5 + 0.01 * jax.random.normal(ks[11], (n_odd, S5_GROUPS, S5_STATE), f32)
    ssm_lam_im = (math.pi * jnp.arange(S5_STATE, dtype=f32)
                  + 0.01 * jax.random.normal(ks[12], (n_odd, S5_GROUPS, S5_STATE), f32))
    ssm_log_dt = jax.random.uniform(ks[13], (n_odd, S5_GROUPS), f32,
                                    minval=math.log(DT_MIN), maxval=math.log(DT_MAX))
    ssm_b_re = nrm(ks[14], (n_odd, S5_GROUPS, S5_STATE, S5_GROUP_CH), (2 * S5_GROUP_CH) ** -0.5)
    ssm_b_im = nrm(ks[15], (n_odd, S5_GROUPS, S5_STATE, S5_GROUP_CH), (2 * S5_GROUP_CH) ** -0.5)
    ssm_c_re = nrm(ks[16], (n_odd, S5_GROUPS, S5_GROUP_CH, S5_STATE), (2 * S5_STATE) ** -0.5)
    ssm_c_im = nrm(ks[17], (n_odd, S5_GROUPS, S5_GROUP_CH, S5_STATE), (2 * S5_STATE) ** -0.5)
    ssm_d = nrm(ks[18], (n_odd, S5_WIDTH), 1.0)
    ssm_w_glu = nrm(ks[19], (n_odd, S5_WIDTH, 2 * D_MODEL), S5_WIDTH ** -0.5)
    moe_w_group = nrm(ks[20], (DEPTH, D_MODEL, MOE_GROUPS), D_MODEL ** -0.5)
    moe_b_group = nrm(ks[21], (DEPTH, MOE_GROUPS), 0.01)
    moe_w_expert = nrm(ks[22], (DEPTH, D_MODEL, MOE_EXPERTS), D_MODEL ** -0.5)
    moe_b_expert = nrm(ks[23], (DEPTH, MOE_EXPERTS), 0.01)
    moe_w_gate_up = nrm(ks[24], (DEPTH, MOE_EXPERTS, D_MODEL, 2 * MOE_FF), D_MODEL ** -0.5)
    moe_w_down = nrm(ks[25], (DEPTH, MOE_EXPERTS, MOE_FF, D_MODEL), MOE_FF ** -0.5)
    return {
        'x': x, 'positions': positions,
        'norm_mix': norm_mix, 'norm_ffn': norm_ffn, 'norm_final': norm_final,
        'attn_w_in': attn_w_in, 'attn_q_norm': attn_q_norm, 'attn_kv_norm': attn_kv_norm,
        'attn_w_uq': attn_w_uq, 'attn_w_ukv': attn_w_ukv, 'attn_w_out': attn_w_out,
        'ssm_w_in': ssm_w_in, 'ssm_lam_re': ssm_lam_re, 'ssm_lam_im': ssm_lam_im,
        'ssm_log_dt': ssm_log_dt, 'ssm_b_re': ssm_b_re, 'ssm_b_im': ssm_b_im,
        'ssm_c_re': ssm_c_re, 'ssm_c_im': ssm_c_im, 'ssm_d': ssm_d, 'ssm_w_glu': ssm_w_glu,
        'moe_w_group': moe_w_group, 'moe_b_group': moe_b_group,
        'moe_w_expert': moe_w_expert, 'moe_b_expert': moe_b_expert,
        'moe_w_gate_up': moe_w_gate_up, 'moe_w_down': moe_w_down,
    }


def reference(x, positions, norm_mix, norm_ffn, norm_final,
              attn_w_in, attn_q_norm, attn_kv_norm, attn_w_uq, attn_w_ukv, attn_w_out,
              ssm_w_in, ssm_lam_re, ssm_lam_im, ssm_log_dt, ssm_b_re, ssm_b_im,
              ssm_c_re, ssm_c_im, ssm_d, ssm_w_glu,
              moe_w_group, moe_b_group, moe_w_expert, moe_b_expert,
              moe_w_gate_up, moe_w_down):
    for layer in range(DEPTH):
        i = layer // 2
        h = _rmsnorm(x, norm_mix[layer])
        if layer % 2 == 0:
            x = x + _attention_layer(h, positions, attn_w_in[i], attn_q_norm[i], attn_kv_norm[i],
                                     attn_w_uq[i], attn_w_ukv[i], attn_w_out[i])
        else:
            x = x + _s5_layer(h, ssm_w_in[i], ssm_lam_re[i], ssm_lam_im[i], ssm_log_dt[i],
                              ssm_b_re[i], ssm_b_im[i], ssm_c_re[i], ssm_c_im[i], ssm_d[i],
                              ssm_w_glu[i])
        h = _rmsnorm(x, norm_ffn[layer])
        x = x + _hier_moe(h, moe_w_group[layer], moe_b_group[layer], moe_w_expert[layer],
                          moe_b_expert[layer], moe_w_gate_up[layer], moe_w_down[layer])
    return _rmsnorm(x, norm_final)
```

```cpp
#define MODE 2
#include <hip/hip_runtime.h>
#include <stdint.h>
#include <stdio.h>

constexpr int DM = 4096, NB = 4, SEQ = 2048, T = NB * SEQ;
constexpr int PW = 5776;
constexpr int OFF_QA = 0, OFF_KA = 2048, OFF_VA = 2560, OFF_IQ = 3072, OFF_IK = 4096, OFF_IW = 4160, OFF_CQ = 4176, OFF_CKV = 5200, OFF_KR = 5712;
constexpr int NSEL = 256;
constexpr int S5W = 2048, S5G = 128, S5P = 64, S5C = 16;
constexpr int NE = 32, NGRP = 4, EPG = 8, FF = 512, NPAIR = T * 2;


#define GAS __attribute__((address_space(1)))
#define LAS __attribute__((address_space(3)))
typedef unsigned short bf16_t;
typedef short bf16x8 __attribute__((ext_vector_type(8)));
typedef short s16x4 __attribute__((ext_vector_type(4)));
typedef float f32x2 __attribute__((ext_vector_type(2)));
typedef float f32x4 __attribute__((ext_vector_type(4)));
typedef float f32x16 __attribute__((ext_vector_type(16)));
typedef unsigned u32x2 __attribute__((ext_vector_type(2)));
typedef unsigned u32x4 __attribute__((ext_vector_type(4)));
typedef int i32x4 __attribute__((ext_vector_type(4)));
typedef GAS unsigned gu32;
#define RLX_AGENT __ATOMIC_RELAXED, __HIP_MEMORY_SCOPE_AGENT

typedef __bf16 bf16x2_hw __attribute__((ext_vector_type(2)));
__device__ __forceinline__ unsigned cvt_pk_bf16(float lo, float hi) { const f32x2 v = {lo, hi}; const bf16x2_hw b = __builtin_convertvector(v, bf16x2_hw); return __builtin_bit_cast(unsigned, b); }
__device__ __forceinline__ float bf_lo(unsigned w) { return __uint_as_float(w << 16); }
__device__ __forceinline__ float bf_hi(unsigned w) { return __uint_as_float(w & 0xffff0000u); }
__device__ __forceinline__ void st_wt(unsigned* p, unsigned v) { __hip_atomic_store(p, v, __ATOMIC_RELAXED, __HIP_MEMORY_SCOPE_AGENT); }
__device__ __forceinline__ void st_wt(int* p, int v) { __hip_atomic_store(p, v, __ATOMIC_RELAXED, __HIP_MEMORY_SCOPE_AGENT); }
__device__ __forceinline__ void st_wt(float* p, float v) { __hip_atomic_store((unsigned*)p, __float_as_uint(v), __ATOMIC_RELAXED, __HIP_MEMORY_SCOPE_AGENT); }
__device__ __forceinline__ void st_wt8(void* p, unsigned lo, unsigned hi) { __hip_atomic_store((unsigned long long*)p, ((unsigned long long)hi << 32) | lo, __ATOMIC_RELAXED, __HIP_MEMORY_SCOPE_AGENT); }
__device__ __forceinline__ float wave_sum(float v) {
#pragma unroll
    for (int o = 1; o < 64; o <<= 1) v += __shfl_xor(v, o);
    return v;
}

constexpr int PWF = 5888;
constexpr int FC_QA = 0, FC_KA = 2048, FC_VA = 2560, FC_IQ = 3072, FC_CQ = 4096, FC_CKV = 5120, FC_IK = 5632, FC_KR = 5696, FC_IW = 5760;
constexpr int MAXROWS = 24576;
constexpr size_t alz(size_t x) { return (x + 4095) & ~(size_t)4095; }
constexpr size_t F_CTL = 0, F_CTL_B = (size_t)1 << 20;
constexpr size_t F_BT1 = F_CTL + F_CTL_B;                     constexpr size_t F_BT1_B = alz((size_t)PWF * 4096 * 2);
constexpr size_t F_BT2A = F_BT1 + F_BT1_B;                    constexpr size_t F_BT2A_B = alz((size_t)3072 * 1024 * 2);
constexpr size_t F_BT2B = F_BT2A + F_BT2A_B;                  constexpr size_t F_BT2B_B = alz((size_t)4096 * 512 * 2);
constexpr size_t F_BT3 = F_BT2B + F_BT2B_B;                   constexpr size_t F_BT3_B = alz((size_t)4096 * 4096 * 2);
constexpr size_t F_BT4 = F_BT3 + F_BT3_B;                     constexpr size_t F_BT4_B = alz((size_t)2048 * 4096 * 2);
constexpr size_t F_BT5 = F_BT4 + F_BT4_B;                     constexpr size_t F_BT5_B = alz((size_t)8192 * 2048 * 2);
constexpr size_t F_BTR = F_BT5 + F_BT5_B;                     constexpr size_t F_BTR_B = alz((size_t)2 * 256 * 4096 * 2);
constexpr size_t F_BTGU = F_BTR + F_BTR_B;                    constexpr size_t F_BTGU_B = alz((size_t)2 * 32 * 1024 * 4096 * 2);
constexpr size_t F_BTDN = F_BTGU + F_BTGU_B;                  constexpr size_t F_BTDN_B = alz((size_t)2 * 32 * 4096 * 512 * 2);
constexpr size_t F_HN = F_BTDN + F_BTDN_B;                    constexpr size_t F_HN_B = 2 * alz((size_t)T * 4096 * 2);
constexpr size_t F_P = F_HN + F_HN_B;                         constexpr size_t F_P_B = alz((size_t)T * PWF * 2);
constexpr size_t F_STQ = F_P + F_P_B;                         constexpr size_t F_STQ_B = alz((size_t)T * 16 * 4);
constexpr size_t F_STKV = F_STQ + F_STQ_B;                    constexpr size_t F_STKV_B = alz((size_t)T * 8 * 4);
constexpr size_t F_MASK = F_STKV + F_STKV_B;                  constexpr size_t F_MASK_B = alz((size_t)T * 64 * 4);
constexpr size_t F_Q = F_MASK + F_MASK_B;                     constexpr size_t F_Q_B = alz((size_t)T * 3072 * 2);
constexpr size_t F_KV = F_Q + F_Q_B;                          constexpr size_t F_KV_B = alz((size_t)T * 4096 * 2);
constexpr size_t F_CC = F_KV + F_KV_B;                        constexpr size_t F_CC_B = alz((size_t)T * 4096 * 2);
constexpr size_t F_XA = F_CC + F_CC_B;                        constexpr size_t F_XA_B = alz((size_t)T * 4096 * 4);
constexpr size_t F_XB = F_XA + F_XA_B;                        constexpr size_t F_XB_B = alz((size_t)T * 4096 * 4);
constexpr size_t F_LOG = F_XB + F_XB_B;                       constexpr size_t F_LOG_B = 2 * alz((size_t)8 * T * 64 * 4);
constexpr size_t F_EID = F_LOG + F_LOG_B;                     constexpr size_t F_EID_B = 2 * alz((size_t)NPAIR * 4);
constexpr size_t F_WT = F_EID + F_EID_B;                      constexpr size_t F_WT_B = 2 * alz((size_t)NPAIR * 4);
constexpr size_t F_HIST = F_WT + F_WT_B;                      constexpr size_t F_HIST_B = 2 * alz((size_t)256 * 32 * 4);
constexpr size_t F_CNT = F_HIST + F_HIST_B;                   constexpr size_t F_CNT_B = 2 * 4096;
constexpr size_t F_PROW = F_CNT + F_CNT_B;                    constexpr size_t F_PROW_B = 2 * alz((size_t)MAXROWS * 4);
constexpr size_t F_WROW = F_PROW + F_PROW_B;                  constexpr size_t F_WROW_B = 2 * alz((size_t)MAXROWS * 4);
constexpr size_t F_AG = F_WROW + F_WROW_B;                    constexpr size_t F_AG_B = 4096;
constexpr size_t F_ACT = F_AG + F_AG_B;                       constexpr size_t F_ACT_B = 2 * alz((size_t)MAXROWS * 512 * 2);
constexpr size_t F_Y = F_ACT + F_ACT_B;                       constexpr size_t F_Y_B = alz((size_t)NPAIR * 4096 * 2);
constexpr size_t F_U = F_Y + F_Y_B;                           constexpr size_t F_U_B = alz((size_t)T * 2048 * 2);
constexpr size_t F_YG = F_U + F_U_B;                          constexpr size_t F_YG_B = alz((size_t)T * 2048 * 2);
constexpr size_t F_ELOC = F_YG + F_YG_B;                      constexpr size_t F_ELOC_B = alz((size_t)NB * S5G * 8 * S5P * 2 * 4);
constexpr size_t F_SS = F_ELOC + F_ELOC_B;                    constexpr size_t F_SS_B = 2 * alz((size_t)T * 128 * 4);
constexpr size_t F_RSTD = F_SS + F_SS_B;                      constexpr size_t F_RSTD_B = 2 * alz((size_t)T * 4);
constexpr size_t F_RS4 = F_RSTD + F_RSTD_B;                   constexpr size_t F_RS4_B = alz((size_t)T * 4);
constexpr size_t F_RS1 = F_RS4 + F_RS4_B;                     constexpr size_t F_RS1_B = alz((size_t)T * 4);
constexpr size_t F_END = F_RS1 + F_RS1_B;

constexpr int CW_TMO = 0, CW_BAR = 4096;
constexpr int LDS_BYTES = 147456;
constexpr int MISC_OFF = 131072 + 8192;
constexpr int TAB_OFF = 131072;

#define XB_TMO      128
#define XB_XCNT(j)  (256  + 64 * (j))
#define XB_XSUB(j)  (1280 + 64 * (j))
#define XB_XGEN(j)  (2304 + 64 * (j))
#define XB_TOP      3328
#define XB_TOPGEN   3392
#define XCD_BAR_WORDS 3456
#define XB_SPIN_CAP (1u << 18)
__device__ __forceinline__ unsigned xb_ld(unsigned* p)              { return __hip_atomic_load(p, __ATOMIC_RELAXED, __HIP_MEMORY_SCOPE_AGENT); }
__device__ __forceinline__ unsigned xb_add(unsigned* p, unsigned v) { return __hip_atomic_fetch_add(p, v, __ATOMIC_RELAXED, __HIP_MEMORY_SCOPE_AGENT); }
__device__ __forceinline__ unsigned xb_xcc_id() { return (unsigned)__builtin_amdgcn_s_getreg((3 << 11) | 20) & 0xFu; }
#define XB_SPIN(cond, bar) do { unsigned _sp = 0; while (cond) { __builtin_amdgcn_s_sleep(1); \
    if ((++_sp & 255u) == 0u) { if (xb_ld(&(bar)[XB_TMO])) break; if (_sp > XB_SPIN_CAP) { atomicAdd(&(bar)[XB_TMO], 1u); break; } } } } while (0)
struct XcdBarrier { unsigned* bar; unsigned x; volatile LAS unsigned* st; };
__device__ __forceinline__ XcdBarrier xcd_barrier_post(unsigned* bar, volatile LAS unsigned* st) {
    XcdBarrier b; b.bar = bar; b.x = xb_xcc_id(); b.st = st;
    if (threadIdx.x == 0) (void)xb_add(&bar[XB_XCNT(b.x)], 1u);
    return b;
}
__device__ __forceinline__ void xcd_barrier_complete(unsigned* bar, unsigned x, unsigned& nloc, unsigned& nx) {
    const unsigned G = gridDim.x * gridDim.y * gridDim.z;
    unsigned sum, cnt, mine, sp = 0u;
    for (;;) {
        sum = 0u; cnt = 0u; mine = 0u;
#pragma unroll
        for (unsigned j = 0; j < 16; ++j) { const unsigned c = xb_ld(&bar[XB_XCNT(j)]); sum += c; cnt += (c > 0u) ? 1u : 0u; mine = (j == x) ? c : mine; }
        if (sum == G) break;
        __builtin_amdgcn_s_sleep(1);
        if ((++sp & 255u) == 0u) { if (xb_ld(&bar[XB_TMO])) break; if (sp > XB_SPIN_CAP) { atomicAdd(&bar[XB_TMO], 1u); break; } }
    }
    nloc = mine > 0u ? mine : 1u; nx = cnt > 0u ? cnt : 1u;
}
__device__ __forceinline__ void xcd_barrier(const XcdBarrier& b) {
    asm volatile("s_waitcnt vmcnt(0)" ::: "memory");
    __syncthreads();
    if (threadIdx.x == 0) {
        unsigned* bar = b.bar;
        __builtin_amdgcn_s_waitcnt(0);
        unsigned nloc = b.st[0], nx = b.st[1];
        if (nloc == 0u) { xcd_barrier_complete(bar, b.x, nloc, nx); b.st[0] = nloc; b.st[1] = nx; }
        const unsigned old = xb_add(&bar[XB_XSUB(b.x)], 1u);
        const unsigned gen = old / nloc;
        if (old + 1u == (gen + 1u) * nloc) {
            __builtin_amdgcn_fence(__ATOMIC_RELEASE, "agent");
            asm volatile("s_waitcnt vmcnt(0)" ::: "memory");
            const unsigned og = xb_add(&bar[XB_TOP], 1u);
            const unsigned tg = og / nx;
            if (og + 1u == (tg + 1u) * nx) xb_add(&bar[XB_TOPGEN], 1u);
            else XB_SPIN(xb_ld(&bar[XB_TOPGEN]) == tg, bar);
            __builtin_amdgcn_fence(__ATOMIC_ACQUIRE, "agent");
            xb_add(&bar[XB_XGEN(b.x)], 1u);
            asm volatile("s_waitcnt vmcnt(0)" ::: "memory");
        } else {
            XB_SPIN(xb_ld(&bar[XB_XGEN(b.x)]) == gen, bar);
            __builtin_amdgcn_fence(__ATOMIC_ACQUIRE, "agent");
            asm volatile("s_waitcnt vmcnt(0)" ::: "memory");
        }
    }
    __syncthreads();
}

struct MapId   { __device__ __forceinline__ int operator()(int n) const { return n; } };
struct MapG1   { __device__ __forceinline__ int operator()(int n) const {
    if (n < 4096) return n;
    if (n < 4160) return FC_IK + (n - 4096);
    if (n < 4176) return FC_IW + (n - 4160);
    if (n < 5200) return FC_CQ + (n - 4176);
    if (n < 5712) return FC_CKV + (n - 5200);
    const int i = n - 5712; return FC_KR + ((i < 32) ? 2 * i : 2 * (i - 32) + 1); } };
struct MapUQ   { __device__ __forceinline__ int operator()(int n) const { const int h = n / 192, d = n % 192;
    if (d < 128) return h * 128 + d; const int i = d - 128; return 2048 + h * 64 + ((i < 32) ? 2 * i : 2 * (i - 32) + 1); } };
struct MapUKV  { __device__ __forceinline__ int operator()(int n) const { const int h = n >> 8, d = n & 255; return (d < 128) ? h * 128 + d : 2048 + h * 128 + (d - 128); } };
struct MapPair { int half; __device__ __forceinline__ int operator()(int n) const { const int hi = n >= half, j = hi ? n - half : n; return (j >> 7) * 256 + hi * 128 + (j & 127); } };
struct MapOff  { int off; __device__ __forceinline__ int operator()(int n) const { return n + off; } };

template <class Map>
__device__ __forceinline__ void tr_item(const float* __restrict__ W, int K, int N, bf16_t* WT, const float* __restrict__ kscale, int item, int lane, const Map& map) {
    const int nblk = (N + 31) >> 5, kb = item / nblk, nb = item - kb * nblk;
    const int c = lane & 7, nq = lane >> 3;
    const int k0 = kb * 64 + 8 * c, n = nb * 32 + 4 * nq;
    if (n < N) {
        f32x4 v[8];
#pragma unroll
        for (int i = 0; i < 8; ++i) v[i] = *(const f32x4*)(W + (size_t)(k0 + i) * N + n);
        if (kscale) {
#pragma unroll
            for (int i = 0; i < 8; ++i) v[i] *= kscale[k0 + i];
        }
#pragma unroll
        for (int j = 0; j < 4; ++j) {
            u32x4 o; o.x = cvt_pk_bf16(v[0][j], v[1][j]); o.y = cvt_pk_bf16(v[2][j], v[3][j]); o.z = cvt_pk_bf16(v[4][j], v[5][j]); o.w = cvt_pk_bf16(v[6][j], v[7][j]);
            *(u32x4*)(WT + (size_t)map(n + j) * K + k0) = o;
        }
    }
}
__device__ __forceinline__ void moe_conv4(const float* __restrict__ Wgu, const float* __restrict__ Wdn, bf16_t* Tgu, bf16_t* Tdn, const float* __restrict__ ks, int L, int id0, int step, int end, int lane) {
    const int c = lane & 7, nq = lane >> 3;
    f32x4 v[4][8], kv[4][2];
#pragma unroll
    for (int b = 0; b < 4; ++b) {
        const int id = id0 + b * step;
        if (id < end) {
            const int e = id / 3072, j = id - e * 3072, le = L * 32 + e; const bool gu = j < 2048; const int jj = gu ? j : j - 2048;
            const int N = gu ? 1024 : 4096, kb = gu ? (jj >> 5) : (jj >> 7), nb = gu ? (jj & 31) : (jj & 127), k0 = kb * 64 + 8 * c;
            const float* src = (gu ? Wgu + (size_t)le * 4096 * 1024 : Wdn + (size_t)le * 512 * 4096) + (size_t)k0 * N + nb * 32 + 4 * nq;
#pragma unroll
            for (int i = 0; i < 8; ++i) v[b][i] = *(const f32x4*)(src + (size_t)i * N);
            if (gu) { kv[b][0] = *(const f32x4*)(ks + k0); kv[b][1] = *(const f32x4*)(ks + k0 + 4); }
        }
    }
#pragma unroll
    for (int b = 0; b < 4; ++b) {
        const int id = id0 + b * step;
        if (id < end) {
            const int e = id / 3072, j = id - e * 3072, le = L * 32 + e; const bool gu = j < 2048; const int jj = gu ? j : j - 2048;
            const int K = gu ? 4096 : 512, kb = gu ? (jj >> 5) : (jj >> 7), nb = gu ? (jj & 31) : (jj & 127), k0 = kb * 64 + 8 * c, n = nb * 32 + 4 * nq;
            if (gu) {
#pragma unroll
                for (int i = 0; i < 8; ++i) v[b][i] *= kv[b][i >> 2][i & 3];
            }
            bf16_t* dst = (gu ? Tgu + (size_t)le * 1024 * 4096 : Tdn + (size_t)le * 4096 * 512) + k0;
#pragma unroll
            for (int q = 0; q < 4; ++q) {
                u32x4 o; o.x = cvt_pk_bf16(v[b][0][q], v[b][1][q]); o.y = cvt_pk_bf16(v[b][2][q], v[b][3][q]); o.z = cvt_pk_bf16(v[b][4][q], v[b][5][q]); o.w = cvt_pk_bf16(v[b][6][q], v[b][7][q]);
                const int row = gu ? MapPair{512}(n + q) : n + q;
                *(u32x4*)(dst + (size_t)row * K) = o;
            }
        }
    }
}
template <class Map>
__device__ __forceinline__ void tr_matrix(const float* W, int K, int N, bf16_t* WT, const float* kscale, int gw, int NGW, int lane, const Map& map) {
    const int nitems = (K >> 6) * ((N + 31) >> 5);
    for (int it = gw; it < nitems; it += NGW) tr_item(W, K, N, WT, kscale, it, lane, map);
}
__device__ __forceinline__ void cast_row_bf16(const float* xrow, bf16_t* orow, float* rs_out, int lane) {
    f32x4 v[16]; float s = 0.f;
#pragma unroll
    for (int j = 0; j < 16; ++j) { v[j] = ((const f32x4*)xrow)[lane + 64 * j]; s += (v[j].x * v[j].x + v[j].y * v[j].y) + (v[j].z * v[j].z + v[j].w * v[j].w); }
#pragma unroll
    for (int j = 0; j < 16; ++j) { u32x2 o; o.x = cvt_pk_bf16(v[j].x, v[j].y); o.y = cvt_pk_bf16(v[j].z, v[j].w); ((u32x2*)orow)[lane + 64 * j] = o; }
    const float rstd = rsqrtf(wave_sum(s) * (1.f / 4096.f) + 1e-6f);
    if (lane == 0) st_wt(rs_out, rstd);
}
__device__ __forceinline__ void norm_row_bf16(const float* xrow, const float* g, bf16_t* orow, int lane) {
    f32x4 v[16]; float s = 0.f;
#pragma unroll
    for (int j = 0; j < 16; ++j) { v[j] = ((const f32x4*)xrow)[lane + 64 * j]; s += (v[j].x * v[j].x + v[j].y * v[j].y) + (v[j].z * v[j].z + v[j].w * v[j].w); }
    const float rstd = rsqrtf(wave_sum(s) * (1.f / 4096.f) + 1e-6f);
#pragma unroll
    for (int j = 0; j < 16; ++j) { const f32x4 gg = ((const f32x4*)g)[lane + 64 * j];
        u32x2 o; o.x = cvt_pk_bf16(v[j].x * rstd * gg.x, v[j].y * rstd * gg.y); o.y = cvt_pk_bf16(v[j].z * rstd * gg.z, v[j].w * rstd * gg.w);
        ((u32x2*)orow)[lane + 64 * j] = o; }
}

namespace pg {
constexpr int BM = 256, BK = 64, HALF = 128, HTB = HALF * BK * 2, STAGE_BYTES = 8 * HTB, NXCD = 8, WGM = 8;
__host__ __device__ __forceinline__ int lds_byte(int r, int c) { const int st = (r >> 4) * 2 + (c >> 5), rr = r & 15, cc = c & 31, ob = rr * 64 + cc * 2; return st * 1024 + (ob ^ (((ob >> 9) & 1) << 5)); }
__host__ __device__ __forceinline__ void stage_rc(int b, int& R, int& C) { const int st = b / 1024, sb = b % 1024, swz = sb ^ (((sb >> 9) & 1) << 5); R = (st >> 1) * 16 + swz / 64; C = (st & 1) * 32 + (swz % 64) / 2; }
struct GUnit { const char* A; const char* B; int pm, pn, e, rows; };
#define EPI_ARGS const f32x4 (&acc)[2][2][4][2], const pg::GUnit& u, int wr, int wc, int fr, int fq

struct PlainSched {
    const char* A; const char* B; size_t tstepA, tstepB; int nM, nN, nwg, G, c, cnt;
    __device__ __forceinline__ void init(const void* A_, size_t ldaB, const void* B_, int K, int M, int N, int G_, int c_) {
        A = (const char*)A_; B = (const char*)B_; tstepA = 256 * ldaB; tstepB = (size_t)256 * K * 2; nM = M / BM; nN = N / BM; nwg = nM * nN; G = G_; c = c_; cnt = 1 << 30; }
    __device__ __forceinline__ void deal(int first, int step, int count) { c = first; G = step; cnt = count; }
    __device__ __forceinline__ bool next(int i, GUnit& u) const {
        const long L = (long)i * G + c; if (L >= nwg || i >= cnt) return false;
        int wgid = (int)L; { const int q = nwg / NXCD, r = nwg % NXCD, xcd = wgid % NXCD, off = wgid / NXCD; wgid = (xcd < r ? xcd * (q + 1) : r * (q + 1) + (xcd - r) * q) + off; }
        const int nig = WGM * nN, gid = wgid / nig, fm = gid * WGM, gsz = (nM - fm) < WGM ? (nM - fm) : WGM;
        u.pm = fm + ((wgid % nig) % gsz); u.pn = (wgid % nig) / gsz; u.e = 0; u.rows = 256;
        u.A = A + (size_t)u.pm * tstepA; u.B = B + (size_t)u.pn * tstepB; return true;
    }
};
struct RouterSched {
    const char* A; const char* B; int G, c;
    __device__ __forceinline__ bool next(int i, GUnit& u) const {
        const int L = i * G + c; if (L >= 256) return false;
        u.pm = L >> 3; u.pn = L & 7; u.e = 0; u.rows = 256;
        u.A = A + (size_t)u.pm * 256 * 8192 + (size_t)u.pn * 1024; u.B = B + (size_t)u.pn * 1024; return true;
    }
};
struct MoeSched {
    const char* A; const char* B; const unsigned* cnt; size_t ldaB, tstepB, bexp; int NT, ntsh, G, c; int gather; int first, step, lim; LAS const unsigned char* tab;
    __device__ __forceinline__ void load_counts(LAS unsigned char* lds) {
        tab = lds + TAB_OFF;
        if (threadIdx.x < 64) {
            const int l = threadIdx.x & 63;
            const int n = (int)__hip_atomic_load(cnt + (l & 31), RLX_AGENT);
            const int mf = n >> 8, rem = n & 255;
            int u1 = (mf + (rem > 128 ? 1 : 0)) * NT, u2 = (rem > 0 && rem <= 128) ? NT : 0, pd = ((n + 255) >> 8) * 256;
            if (l >= 32) { u1 = 0; u2 = 0; pd = 0; }
            int s1 = u1, s2 = u2, sp = pd;
#pragma unroll
            for (int d = 1; d < 32; d <<= 1) { const int t1 = __shfl_up(s1, d), t2 = __shfl_up(s2, d), tp = __shfl_up(sp, d); if (l >= d) { s1 += t1; s2 += t2; sp += tp; } }
            const int tot1 = __shfl(s1, 31), tot2 = __shfl(s2, 31);
            if (l < 32) *(LAS i32x4*)(lds + TAB_OFF + l * 16) = (i32x4){s1 - u1, tot1 + s2 - u2, sp - pd, n};
            if (l == 32) *(LAS i32x4*)(lds + TAB_OFF + 32 * 16) = (i32x4){tot1, tot2, 0, 0};
        }
        __syncthreads();
    }
    __device__ __forceinline__ int total() const { const i32x4 g = *(LAS const i32x4*)(tab + 32 * 16); return __builtin_amdgcn_readfirstlane(g.x + g.y); }
    __device__ __forceinline__ int u1() const { const i32x4 g = *(LAS const i32x4*)(tab + 32 * 16); return __builtin_amdgcn_readfirstlane(g.x); }
    __device__ __forceinline__ bool next(int i, GUnit& u) const {
        if (i >= lim) return false;
        const int L = first + i * step;
        const i32x4 t = *(LAS const i32x4*)(tab + (threadIdx.x & 31) * 16);
        const int n = t.w, mf = n >> 8, rem = n & 255;
        const int u1 = (mf + (rem > 128 ? 1 : 0)) * NT, u2 = (rem > 0 && rem <= 128) ? NT : 0;
        const unsigned long long m1 = __ballot(L >= t.x && L < t.x + u1), m2 = __ballot(L >= t.y && L < t.y + u2);
        if ((m1 | m2) == 0ull) return false;
        const bool p1 = m1 != 0ull;
        const int e = __builtin_ctzll(p1 ? m1 : m2);
        const int ne = __builtin_amdgcn_readlane(n, e), rowbase = __builtin_amdgcn_readlane(t.z, e);
        const int loc = L - (p1 ? __builtin_amdgcn_readlane(t.x, e) : __builtin_amdgcn_readlane(t.y, e));
        const int mfe = ne >> 8, reme = ne & 255;
        const int m = p1 ? (loc >> ntsh) : mfe, nt = p1 ? (loc & (NT - 1)) : loc;
        u.pm = (rowbase >> 8) + m; u.pn = nt; u.e = e; u.rows = (m < mfe) ? 256 : reme;
        u.A = gather ? A : A + (size_t)(rowbase + m * 256) * ldaB; u.B = B + (size_t)e * bexp + (size_t)nt * tstepB; return true;
    }
};

template <class Epi, class Sched, bool GATHER = false, bool SKIPDEAD = false>
__device__ __forceinline__ void gemm_phase(LAS unsigned char* lds, const int K, const size_t ldaB, const Sched& S, const Epi& E, const size_t ldbB_ = 0, const int* rowtab = nullptr) {
    int tid = threadIdx.x; asm volatile("" : "+v"(tid));
    const int wid = __builtin_amdgcn_readfirstlane(tid >> 6), lane = tid & 63, wr = wid >> 2, wc = wid & 3, fr = lane & 15, fq = lane >> 4;
    const int nt = K / BK; const size_t ldbB = ldbB_ ? ldbB_ : (size_t)K * 2;
    unsigned voffA[2], voffB[2]; int gR[2], gC[2];
#pragma unroll
    for (int i = 0; i < 2; ++i) { int R, C; stage_rc(tid * 16 + i * 8192, R, C); gR[i] = R; gC[i] = C * 2; voffA[i] = (unsigned)(R * ldaB + C * 2); voffB[i] = (unsigned)(R * ldbB + C * 2); }
    unsigned gcur[2][2], gnxt[2][2];
#define PG_GOFF(dst, uu) do { _Pragma("unroll") for (int h_ = 0; h_ < 2; ++h_) _Pragma("unroll") for (int i_ = 0; i_ < 2; ++i_) \
        dst[h_][i_] = (unsigned)(rowtab[(uu).pm * 256 + h_ * 128 + gR[i_]] >> 1) * (unsigned)ldaB + (unsigned)gC[i_]; } while (0)
    const size_t kstep = (size_t)(BK * 2);
    const size_t hstepA = (size_t)HALF * ldaB, hstepB = (size_t)HALF * ldbB;
    const unsigned ldsw = (unsigned)wid * 1024u;
    const int aoff = lds_byte(wr * 64 + fr, fq * 8), boff = lds_byte(wc * 32 + fr, fq * 8);
#define PG_SA(b, h) (((b) * 2 + (h)) * HTB)
#define PG_SB(b, h) ((4 + (b) * 2 + (h)) * HTB)
#define PG_STAGE(bufoff, gbase, voff) do { _Pragma("unroll") for (int _i = 0; _i < 2; ++_i) \
        __builtin_amdgcn_global_load_lds((const unsigned*)((const char*)(gbase) + (voff)[_i]), (LAS unsigned*)(lds + (bufoff) + ldsw + _i * 8192), 16, 0, 0); } while (0)
#define PG_STAGE_A(bufoff, gbase, h, isnext) do { if constexpr (GATHER) { _Pragma("unroll") for (int _i = 0; _i < 2; ++_i) \
        __builtin_amdgcn_global_load_lds((const unsigned*)((const char*)(gbase) + ((isnext) ? gnxt[h][_i] : gcur[h][_i])), (LAS unsigned*)(lds + (bufoff) + ldsw + _i * 8192), 16, 0, 0); } \
        else { PG_STAGE(bufoff, (gbase) + (h) * hstepA, voffA); } } while (0)
#define PG_LDA(dst, b, h) do { _Pragma("unroll") for (int m = 0; m < 4; ++m) _Pragma("unroll") for (int k = 0; k < 2; ++k) dst[m][k] = *(const LAS bf16x8*)(lds + PG_SA(b, h) + aoff + m * 2048 + k * 1024); } while (0)
#define PG_LDB(dst, b, h) do { _Pragma("unroll") for (int n = 0; n < 2; ++n) _Pragma("unroll") for (int k = 0; k < 2; ++k) dst[n][k] = *(const LAS bf16x8*)(lds + PG_SB(b, h) + boff + n * 2048 + k * 1024); } while (0)
#define PG_MMA(ai, bj, At, Bt) do { __builtin_amdgcn_s_setprio(1); _Pragma("unroll") for (int m = 0; m < 4; ++m) _Pragma("unroll") for (int n = 0; n < 2; ++n) _Pragma("unroll") for (int k = 0; k < 2; ++k) \
        acc[ai][bj][m][n] = __builtin_amdgcn_mfma_f32_16x16x32_bf16(Bt[n][k], At[m][k], acc[ai][bj][m][n], 0, 0, 0); __builtin_amdgcn_s_setprio(0); } while (0)
#define PG_WAIT_V(n) asm volatile("s_waitcnt vmcnt(" #n ")" ::: "memory")
#define PG_WAIT_L(n) asm volatile("s_waitcnt lgkmcnt(" #n ")" ::: "memory")
#define PG_BAR __builtin_amdgcn_s_barrier()
#define PG_SCHED __builtin_amdgcn_sched_barrier(0)
    GUnit cur, nxt; int ui = 0;
    if (!S.next(0, cur)) return;
    f32x4 acc[2][2][4][2];
#pragma unroll
    for (int a = 0; a < 2; ++a)
#pragma unroll
        for (int b = 0; b < 2; ++b)
#pragma unroll
            for (int m = 0; m < 4; ++m)
#pragma unroll
                for (int n = 0; n < 2; ++n) acc[a][b][m][n] = (f32x4){0.f, 0.f, 0.f, 0.f};
    bf16x8 At[4][2], B0[2][2], B1[2][2];
    const char* cA = cur.A; const char* cB = cur.B;
    if constexpr (GATHER) { PG_GOFF(gcur, cur); }
    PG_STAGE(PG_SB(0, 0), cB, voffB); PG_STAGE(PG_SB(0, 1), cB + hstepB, voffB); PG_STAGE_A(PG_SA(0, 0), cA, 0, false); PG_STAGE_A(PG_SA(0, 1), cA, 1, false);
    if (wr == 1) PG_BAR;
    PG_WAIT_V(2); PG_BAR;
    PG_STAGE(PG_SB(1, 0), cB + kstep, voffB); PG_STAGE_A(PG_SA(1, 0), cA + kstep, 0, false); PG_STAGE(PG_SB(1, 1), cB + hstepB + kstep, voffB);
    PG_WAIT_V(6); PG_BAR;
    for (;;) {
        const bool has_next = S.next(ui + 1, nxt);
        const char* nA = has_next ? nxt.A : cA; const char* nB = has_next ? nxt.B : cB;
        if constexpr (GATHER) { if (has_next) { PG_GOFF(gnxt, nxt); } }
        const bool live1 = !SKIPDEAD || cur.rows > 128;
        for (int t = 0; t < nt; t += 2) {
            const bool last = (t == nt - 2); const bool nx_ = last && has_next;
            const char* a1 = cA + (size_t)(t + 1) * kstep;
            const char* a2 = last ? nA : cA + (size_t)(t + 2) * kstep; const char* b2 = last ? nB : cB + (size_t)(t + 2) * kstep;
            const char* a3 = a2 + kstep; const char* b3 = b2 + kstep;
            PG_LDB(B0, 0, 0); PG_LDB(B1, 0, 1); PG_SCHED; PG_LDA(At, 0, 0); PG_STAGE_A(PG_SA(1, 1), a1, 1, false);
            PG_WAIT_V(8); PG_WAIT_L(0); PG_BAR; PG_MMA(0, 0, At, B0); PG_MMA(0, 1, At, B1); PG_BAR; PG_SCHED;
            PG_LDA(At, 0, 1); PG_STAGE(PG_SB(0, 0), b2, voffB); PG_STAGE(PG_SB(0, 1), b2 + hstepB, voffB); PG_STAGE_A(PG_SA(0, 0), a2, 0, nx_);
            PG_WAIT_V(8); PG_WAIT_L(0); PG_BAR; if (live1) { PG_MMA(1, 0, At, B0); PG_MMA(1, 1, At, B1); } PG_BAR; PG_SCHED;
            PG_LDB(B0, 1, 0); PG_LDB(B1, 1, 1); PG_SCHED; PG_LDA(At, 1, 0); PG_STAGE_A(PG_SA(0, 1), a2, 1, nx_);
            PG_WAIT_V(8); PG_WAIT_L(0); PG_BAR; PG_MMA(0, 0, At, B0); PG_MMA(0, 1, At, B1); PG_BAR; PG_SCHED;
            PG_LDA(At, 1, 1); PG_STAGE(PG_SB(1, 0), b3, voffB); PG_STAGE(PG_SB(1, 1), b3 + hstepB, voffB); PG_STAGE_A(PG_SA(1, 0), a3, 0, nx_);
            PG_WAIT_V(8); PG_WAIT_L(0); PG_BAR; if (live1) { PG_MMA(1, 0, At, B0); PG_MMA(1, 1, At, B1); } PG_BAR; PG_SCHED;
        }
        if (wr == 0) PG_BAR;
        E(acc, cur, wr, wc, fr, fq);
        if (!has_next) break;
#pragma unroll
        for (int a = 0; a < 2; ++a)
#pragma unroll
            for (int b = 0; b < 2; ++b)
#pragma unroll
                for (int m = 0; m < 4; ++m)
#pragma unroll
                    for (int n = 0; n < 2; ++n) acc[a][b][m][n] = (f32x4){0.f, 0.f, 0.f, 0.f};
        cur = nxt; cA = nA; cB = nB; ++ui;
        if constexpr (GATHER) { _Pragma("unroll") for (int h_ = 0; h_ < 2; ++h_) _Pragma("unroll") for (int i_ = 0; i_ < 2; ++i_) gcur[h_][i_] = gnxt[h_][i_]; }
        if (wr == 1) PG_BAR;
    }
    PG_WAIT_V(0);
    PG_BAR;
    asm volatile("s_waitcnt vmcnt(0) lgkmcnt(0)" ::: "memory"); __syncthreads();
#undef PG_SA
#undef PG_STAGE_A
#undef PG_GOFF
#undef PG_SB
#undef PG_STAGE
#undef PG_LDA
#undef PG_LDB
#undef PG_MMA
#undef PG_WAIT_V
#undef PG_WAIT_L
#undef PG_BAR
#undef PG_SCHED
}
}

__device__ __forceinline__ void rope4(f32x4& v, float pos, int i0) {
#pragma unroll
    for (int h = 0; h < 2; ++h) {
        const float inv = exp2f(-(float)(i0 + h) * 0.41524101186092029f);
        const float ang = pos * inv; const float c = __cosf(ang), s = __sinf(ang);
        const float t1 = v[2 * h], t2 = v[2 * h + 1];
        v[2 * h] = t1 * c - t2 * s; v[2 * h + 1] = t2 * c + t1 * s;
    }
}
struct EpiG1 {
    bf16_t* P; float* statq; float* statkv; const int* pos; const float* rstd;
    __device__ __forceinline__ void operator()(EPI_ARGS) const {
        const int row0 = u.pm * 256 + wr * 64 + fr, colt = u.pn * 256 + wc * 32 + 4 * fq;
        const bool rope_tile = (u.pn == 22) && (wc >= 2);
        const bool sq = (u.pn >= 16 && u.pn < 20), skv = (u.pn == 20 || u.pn == 21);
        float rsv[2][4];
#pragma unroll
        for (int ai = 0; ai < 2; ++ai)
#pragma unroll
            for (int m = 0; m < 4; ++m) rsv[ai][m] = rstd[row0 + ai * 128 + m * 16];
#pragma unroll
        for (int ai = 0; ai < 2; ++ai)
#pragma unroll
            for (int m = 0; m < 4; ++m) {
                const int row = row0 + ai * 128 + m * 16; bf16_t* rowp = P + (size_t)row * PWF + colt; float ss = 0.f;
                const float ps = rope_tile ? (float)pos[row] : 0.f;
#pragma unroll
                for (int bj = 0; bj < 2; ++bj)
#pragma unroll
                    for (int n = 0; n < 2; ++n) { f32x4 v = acc[ai][bj][m][n] * rsv[ai][m];
                        if (rope_tile && bj == 0) { const int i0 = ((wc - 2) * 32 + n * 16 + 4 * fq) >> 1; rope4(v, ps, i0); }
                        ss += (v[0] * v[0] + v[1] * v[1]) + (v[2] * v[2] + v[3] * v[3]);
                        u32x2 o; o.x = cvt_pk_bf16(v[0], v[1]); o.y = cvt_pk_bf16(v[2], v[3]); *(u32x2*)(rowp + bj * 128 + n * 16) = o; }
                if (sq || skv) { ss += __shfl_xor(ss, 16); ss += __shfl_xor(ss, 32);
                    if (fq == 0) { if (sq) st_wt(statq + (size_t)row * 16 + (u.pn - 16) * 4 + wc, ss); else st_wt(statkv + (size_t)row * 8 + (u.pn - 20) * 4 + wc, ss); } }
            }
    }
};
template <int NPART, int KDIM, int ROPE_TILE0  > struct EpiNormed {
    bf16_t* O; int ldo; const float* stat; const int* pos;
    __device__ __forceinline__ void operator()(EPI_ARGS) const {
        const int row0 = u.pm * 256 + wr * 64 + fr, colt = u.pn * 256 + wc * 32 + 4 * fq;
        const bool rope_tile = u.pn >= ROPE_TILE0;
#pragma unroll
        for (int ai = 0; ai < 2; ++ai)
#pragma unroll
            for (int m = 0; m < 4; ++m) {
                const int row = row0 + ai * 128 + m * 16; float s = 0.f;
#pragma unroll
                for (int i = 0; i < NPART / 4; ++i) { const f32x4 q = *(const f32x4*)(stat + (size_t)row * NPART + 4 * i); s += (q[0] + q[1]) + (q[2] + q[3]); }
                const float rstd = rsqrtf(s * (1.f / (float)KDIM) + 1e-6f);
                const float ps = rope_tile ? (float)pos[row] : 0.f;
                bf16_t* rowp = O + (size_t)row * ldo + colt;
#pragma unroll
                for (int bj = 0; bj < 2; ++bj)
#pragma unroll
                    for (int n = 0; n < 2; ++n) { f32x4 v = acc[ai][bj][m][n] * rstd;
                        if (rope_tile) { const int i0 = ((bj * 128 + wc * 32 + n * 16 + 4 * fq) & 63) >> 1; rope4(v, ps, i0); }
                        u32x2 o; o.x = cvt_pk_bf16(v[0], v[1]); o.y = cvt_pk_bf16(v[2], v[3]); *(u32x2*)(rowp + bj * 128 + n * 16) = o; }
            }
    }
};
struct EpiRes {
    const bf16_t* Xi; bf16_t* H; float* SS;
    __device__ __forceinline__ void operator()(EPI_ARGS) const {
        const int row0 = u.pm * 256 + wr * 64 + fr, colt = u.pn * 256 + wc * 32 + 4 * fq;
#pragma unroll
        for (int ai = 0; ai < 2; ++ai)
#pragma unroll
            for (int m = 0; m < 4; ++m) { const int row = row0 + ai * 128 + m * 16; const size_t off = (size_t)row * 4096 + colt; float ss = 0.f;
#pragma unroll
                for (int bj = 0; bj < 2; ++bj)
#pragma unroll
                    for (int n = 0; n < 2; ++n) { const u32x2 xr = *(const u32x2*)(Xi + off + bj * 128 + n * 16); const f32x4 o = (f32x4){bf_lo(xr.x), bf_hi(xr.x), bf_lo(xr.y), bf_hi(xr.y)} + acc[ai][bj][m][n];
                        ss += (o[0] * o[0] + o[1] * o[1]) + (o[2] * o[2] + o[3] * o[3]);
                        u32x2 w; w.x = cvt_pk_bf16(o[0], o[1]); w.y = cvt_pk_bf16(o[2], o[3]); *(u32x2*)(H + off + bj * 128 + n * 16) = w; }
                ss += __shfl_xor(ss, 16); ss += __shfl_xor(ss, 32);
                if (fq == 0) st_wt(SS + (size_t)row * 128 + u.pn * 4 + wc, ss); }
    }
};
struct EpiBf16 {
    bf16_t* O; int ldo;
    __device__ __forceinline__ void operator()(EPI_ARGS) const {
        const int row0 = u.pm * 256 + wr * 64 + fr, colt = u.pn * 256 + wc * 32 + 4 * fq;
#pragma unroll
        for (int ai = 0; ai < 2; ++ai)
#pragma unroll
            for (int m = 0; m < 4; ++m) { bf16_t* rowp = O + (size_t)(row0 + ai * 128 + m * 16) * ldo + colt;
#pragma unroll
                for (int bj = 0; bj < 2; ++bj)
#pragma unroll
                    for (int n = 0; n < 2; ++n) { const f32x4 v = acc[ai][bj][m][n]; u32x2 o; o.x = cvt_pk_bf16(v[0], v[1]); o.y = cvt_pk_bf16(v[2], v[3]); *(u32x2*)(rowp + bj * 128 + n * 16) = o; } }
    }
};
struct EpiBf16R {
    bf16_t* O; int ldo; const float* rstd;
    __device__ __forceinline__ void operator()(EPI_ARGS) const {
        const int row0 = u.pm * 256 + wr * 64 + fr, colt = u.pn * 256 + wc * 32 + 4 * fq;
        float rs[2][4];
#pragma unroll
        for (int ai = 0; ai < 2; ++ai)
#pragma unroll
            for (int m = 0; m < 4; ++m) rs[ai][m] = rstd[row0 + ai * 128 + m * 16];
#pragma unroll
        for (int ai = 0; ai < 2; ++ai)
#pragma unroll
            for (int m = 0; m < 4; ++m) { bf16_t* rowp = O + (size_t)(row0 + ai * 128 + m * 16) * ldo + colt;
#pragma unroll
                for (int bj = 0; bj < 2; ++bj)
#pragma unroll
                    for (int n = 0; n < 2; ++n) { const f32x4 v = acc[ai][bj][m][n] * rs[ai][m]; u32x2 o; o.x = cvt_pk_bf16(v[0], v[1]); o.y = cvt_pk_bf16(v[2], v[3]); *(u32x2*)(rowp + bj * 128 + n * 16) = o; } }
    }
};
struct EpiLogits {
    float* L;
    __device__ __forceinline__ void operator()(EPI_ARGS) const {
        if (wc >= 2) return;
        const int row0 = u.pm * 256 + wr * 64 + fr;
#pragma unroll
        for (int ai = 0; ai < 2; ++ai)
#pragma unroll
            for (int m = 0; m < 4; ++m)
#pragma unroll
                for (int n = 0; n < 2; ++n) *(f32x4*)(L + ((size_t)u.pn * T + (row0 + ai * 128 + m * 16)) * 64 + wc * 32 + n * 16 + 4 * fq) = acc[ai][0][m][n];
    }
};
struct EpiSilu {
    bf16_t* Act; const int* prow; const float* rstd; unsigned* tc;
    __device__ __forceinline__ void operator()(EPI_ARGS) const {
        const int row0 = u.pm * 256 + wr * 64 + fr, colt = u.pn * 128 + wc * 32 + 4 * fq;
#pragma unroll
        for (int ai = 0; ai < 2; ++ai)
#pragma unroll
            for (int m = 0; m < 4; ++m) { const int gr = row0 + ai * 128 + m * 16; const float rs = rstd[prow[gr] >> 1]; bf16_t* rowp = Act + (size_t)gr * 512 + colt;
#pragma unroll
                for (int n = 0; n < 2; ++n) { const f32x4 g = acc[ai][0][m][n] * rs, up = acc[ai][1][m][n] * rs; f32x4 h;
#pragma unroll
                    for (int j = 0; j < 4; ++j) h[j] = g[j] / (1.f + __expf(-g[j])) * up[j];
                    st_wt8(rowp + n * 16, cvt_pk_bf16(h[0], h[1]), cvt_pk_bf16(h[2], h[3])); } }
        asm volatile("s_waitcnt vmcnt(0)" ::: "memory");
        if (fr == 0 && fq == 0) (void)__hip_atomic_fetch_add(tc + u.pm * 32, 1u, __ATOMIC_RELAXED, __HIP_MEMORY_SCOPE_AGENT);
    }
};
struct EpiDown {
    bf16_t* Y; const int* prow; const float* wrow;
    __device__ __forceinline__ void operator()(EPI_ARGS) const {
        const int colt = u.pn * 256 + wc * 32 + 4 * fq;
#pragma unroll
        for (int ai = 0; ai < 2; ++ai)
#pragma unroll
            for (int m = 0; m < 4; ++m) { const int lr = ai * 128 + wr * 64 + m * 16 + fr;
                if (lr < u.rows) { const int gr = u.pm * 256 + lr; const int pair = prow[gr]; const float w = wrow[gr]; bf16_t* rowp = Y + (size_t)pair * 4096 + colt;
#pragma unroll
                    for (int bj = 0; bj < 2; ++bj)
#pragma unroll
                        for (int n = 0; n < 2; ++n) { const f32x4 v = acc[ai][bj][m][n] * w; u32x2 o; o.x = cvt_pk_bf16(v[0], v[1]); o.y = cvt_pk_bf16(v[2], v[3]); *(u32x2*)(rowp + bj * 128 + n * 16) = o; } } }
    }
};
struct EpiGlu {
    const bf16_t* Xi; bf16_t* H; float* SS;
    __device__ __forceinline__ void operator()(EPI_ARGS) const {
        const int row0 = u.pm * 256 + wr * 64 + fr, colt = u.pn * 128 + wc * 32 + 4 * fq;
#pragma unroll
        for (int ai = 0; ai < 2; ++ai)
#pragma unroll
            for (int m = 0; m < 4; ++m) { const int row = row0 + ai * 128 + m * 16; const size_t off = (size_t)row * 4096 + colt; float ss = 0.f;
#pragma unroll
                for (int n = 0; n < 2; ++n) { const f32x4 v = acc[ai][0][m][n], g = acc[ai][1][m][n]; const u32x2 xr = *(const u32x2*)(Xi + off + n * 16); f32x4 r = {bf_lo(xr.x), bf_hi(xr.x), bf_lo(xr.y), bf_hi(xr.y)};
#pragma unroll
                    for (int j = 0; j < 4; ++j) r[j] += v[j] / (1.f + __expf(-g[j]));
                    ss += (r[0] * r[0] + r[1] * r[1]) + (r[2] * r[2] + r[3] * r[3]);
                    u32x2 w; w.x = cvt_pk_bf16(r[0], r[1]); w.y = cvt_pk_bf16(r[2], r[3]); *(u32x2*)(H + off + n * 16) = w; }
                ss += __shfl_xor(ss, 16); ss += __shfl_xor(ss, 32);
                if (fq == 0) st_wt(SS + (size_t)row * 128 + u.pn * 4 + wc, ss); }
    }
};

__device__ __forceinline__ void indexer_unit(const bf16_t* __restrict__ P, unsigned* mask, int b, int qp, int lane) {
    const int n = lane & 31, hi = lane >> 5, q0 = 2 * qp;
    const size_t tok0 = (size_t)b * SEQ;
    const int aq = q0 + ((n >> 2) & 1), ah = (n & 3) + 4 * (n >> 3);
    const bf16_t* ap = P + (tok0 + aq) * PWF + FC_IQ + ah * 64 + 8 * hi;
    bf16x8 af[4];
#pragma unroll
    for (int ks = 0; ks < 4; ++ks) af[ks] = *(const bf16x8*)(ap + 16 * ks);
    float w[16];
    { const u32x4 w0 = *(const u32x4*)(P + (tok0 + q0 + hi) * PWF + FC_IW), w1 = *(const u32x4*)(P + (tok0 + q0 + hi) * PWF + FC_IW + 8);
      const float sc_ = 0.03125f;
#pragma unroll
      for (int i = 0; i < 4; ++i) { w[2 * i] = bf_lo(w0[i]) * sc_; w[2 * i + 1] = bf_hi(w0[i]) * sc_; w[8 + 2 * i] = bf_lo(w1[i]) * sc_; w[8 + 2 * i + 1] = bf_hi(w1[i]) * sc_; } }
    const int njt = (q0 + 1) / 32 + 1;
    const int myq = q0 + hi;
    unsigned sc[64];
    const bf16_t* kp = P + (tok0 + n) * PWF + FC_IK + 8 * hi;
    bf16x8 kb[3][4];
#define IDX_LD(jt_) do { const bf16_t* kq_ = kp + (size_t)(jt_) * 32 * PWF; _Pragma("unroll") for (int ks = 0; ks < 4; ++ks) kb[(jt_) % 3][ks] = *(const bf16x8*)(kq_ + 16 * ks); } while (0)
    IDX_LD(0);
    if (1 < njt) IDX_LD(1);
#pragma unroll
    for (int jt = 0; jt < 64; ++jt) {
        unsigned kv = 0u;
        if (jt < njt) {
            if (jt + 2 < 64 && jt + 2 < njt) IDX_LD(jt + 2);
            f32x16 acc = {};
#pragma unroll
            for (int ks = 0; ks < 4; ++ks) acc = __builtin_amdgcn_mfma_f32_32x32x16_bf16(af[ks], kb[jt % 3][ks], acc, 0, 0, 0);
            float s = 0.f;
#pragma unroll
            for (int r = 0; r < 16; ++r) s = fmaf(w[r], fmaxf(acc[r], 0.f), s);
            const unsigned uu = __float_as_uint(s); const unsigned ok = (uu & 0x80000000u) ? ~uu : (uu | 0x80000000u);
            kv = (jt * 32 + n <= myq) ? ok : 0u;
        }
        sc[jt] = kv;
    }
#undef IDX_LD
    const int L = myq + 1;
    unsigned prefix = 0u; bool fin = (L <= NSEL);
    for (int bit = 31; bit >= 0; --bit) {
        const unsigned cand = prefix | (1u << bit);
        int c = 0;
#pragma unroll
        for (int jt = 0; jt < 64; ++jt) c += (sc[jt] >= cand) ? 1 : 0;
#pragma unroll
        for (int o = 1; o < 32; o <<= 1) c += __shfl_xor(c, o);
        if (!fin) { if (c >= NSEL) prefix = cand; if (c == NSEL) fin = true; }
        if (__all(fin)) break;
    }
    if (L <= NSEL) prefix = 1u;
    unsigned mylo = 0u, myhi = 0u;
#pragma unroll
    for (int jt = 0; jt < 64; ++jt) {
        const unsigned long long m = __ballot(sc[jt] >= prefix);
        if (lane == jt) { mylo = (unsigned)m; myhi = (unsigned)(m >> 32); }
    }
    mask[(tok0 + q0) * 64 + lane] = mylo;
    mask[(tok0 + q0 + 1) * 64 + lane] = myhi;
}

namespace att {
constexpr int SHM_V = 16384;
__device__ __forceinline__ int v_st(int k, int c) { const int kk = (k & ~0xC) | ((k & 4) << 1) | ((k & 8) >> 1); return ((kk >> 3) * 4 + (c >> 5)) * 512 + ((kk & 7) * 32 + (c & 31)) * 2; }
__device__ __forceinline__ int v_rd_base(int lane) { return ((lane & 3) << 3) | (((lane >> 2) & 3) << 6) | (((lane >> 4) & 1) << 5) | (((lane >> 5) & 1) << 8); }
constexpr int v_rd_off(int d0, int ks, int half) { return d0 * 512 + ks * 4096 + half * 2048; }
__device__ __forceinline__ int crow(int r, int hi) { return (r & 3) + 8 * (r >> 2) + 4 * hi; }
#define ATT_SBAR() __builtin_amdgcn_sched_barrier(0)

template <int VB>
__device__ __forceinline__ void pv_tile(f32x16* o, int vb0, bf16x8 pa0, bf16x8 pa1, bf16x8 pa2, bf16x8 pa3) {
#define TRRD(dst, off) asm volatile("ds_read_b64_tr_b16 %0, %1 offset:%2" : "=&v"(dst) : "v"(vb0), "i"(off) : "memory")
#define PV_D0(d0) do { s16x4 l0, l1, l2, l3, h0, h1, h2, h3; constexpr int b_ = VB * SHM_V + v_rd_off(d0, 0, 0); \
        TRRD(l0, b_); TRRD(h0, b_ + 2048); TRRD(l1, b_ + 4096); TRRD(h1, b_ + 6144); TRRD(l2, b_ + 8192); TRRD(h2, b_ + 10240); TRRD(l3, b_ + 12288); TRRD(h3, b_ + 14336); \
        asm volatile("s_waitcnt lgkmcnt(0)" ::: "memory"); ATT_SBAR(); \
        o[d0] = __builtin_amdgcn_mfma_f32_32x32x16_bf16(pa0, (bf16x8){l0[0], l0[1], l0[2], l0[3], h0[0], h0[1], h0[2], h0[3]}, o[d0], 0, 0, 0); \
        o[d0] = __builtin_amdgcn_mfma_f32_32x32x16_bf16(pa1, (bf16x8){l1[0], l1[1], l1[2], l1[3], h1[0], h1[1], h1[2], h1[3]}, o[d0], 0, 0, 0); \
        o[d0] = __builtin_amdgcn_mfma_f32_32x32x16_bf16(pa2, (bf16x8){l2[0], l2[1], l2[2], l2[3], h2[0], h2[1], h2[2], h2[3]}, o[d0], 0, 0, 0); \
        o[d0] = __builtin_amdgcn_mfma_f32_32x32x16_bf16(pa3, (bf16x8){l3[0], l3[1], l3[2], l3[3], h3[0], h3[1], h3[2], h3[3]}, o[d0], 0, 0, 0); } while (0)
    PV_D0(0); PV_D0(1); PV_D0(2); PV_D0(3);
#undef PV_D0
#undef TRRD
}

template <int VB, int SUBT>
__device__ __forceinline__ void pv_half(f32x16* o, int vb0, bf16x8 pa0, bf16x8 pa1) {
#define TRRD(dst, off) asm volatile("ds_read_b64_tr_b16 %0, %1 offset:%2" : "=&v"(dst) : "v"(vb0), "i"(off) : "memory")
#define PV_H0(d0) do { s16x4 l0, l1, h0, h1; constexpr int b_ = VB * SHM_V + v_rd_off(d0, 2 * SUBT, 0); \
        TRRD(l0, b_); TRRD(h0, b_ + 2048); TRRD(l1, b_ + 4096); TRRD(h1, b_ + 6144); \
        asm volatile("s_waitcnt lgkmcnt(0)" ::: "memory"); ATT_SBAR(); \
        o[d0] = __builtin_amdgcn_mfma_f32_32x32x16_bf16(pa0, (bf16x8){l0[0], l0[1], l0[2], l0[3], h0[0], h0[1], h0[2], h0[3]}, o[d0], 0, 0, 0); \
        o[d0] = __builtin_amdgcn_mfma_f32_32x32x16_bf16(pa1, (bf16x8){l1[0], l1[1], l1[2], l1[3], h1[0], h1[1], h1[2], h1[3]}, o[d0], 0, 0, 0); } while (0)
    PV_H0(0); PV_H0(1); PV_H0(2); PV_H0(3);
#undef PV_H0
#undef TRRD
}

struct AttPtrs {
    const bf16_t* Qn; int ldq; const bf16_t* Qr; int ldqr;
    const bf16_t* Kn; int ldk; const bf16_t* Kr; int ldkr;
    const bf16_t* V; int ldv; bf16_t* O; int ldo; const unsigned* mask; float c2;
};

template <int DQK, bool BITMASK>
__device__ __forceinline__ void attn_qblock(LAS char* lds, const AttPtrs& A, const int qb) {
    constexpr int KROW = DQK * 2 + 16, KBUF = 64 * KROW, NKC = DQK / 8, KPT = NKC / 8;
    int tid = threadIdx.x; asm volatile("" : "+v"(tid));
    const int wid = __builtin_amdgcn_readfirstlane(tid >> 6), lane = tid & 63, r32 = lane & 31, hi = lane >> 5;
    if (wid >= 4) __builtin_amdgcn_s_setprio(1);
    LAS char* V_lds = lds; LAS char* K_lds = lds + 2 * SHM_V;
    LAS float* wsf = (LAS float*)(lds + 2 * SHM_V + 2 * KBUF) + wid * 64; LAS float* li_l = wsf; LAS float* al_l = wsf + 32;
    const int qlo = qb * 256 + wid * 32, qrow = qlo + r32;
    const float c2 = A.c2;
    bf16x8 qr[8];
#pragma unroll
    for (int d0 = 0; d0 < 8; ++d0) qr[d0] = *(const bf16x8*)(A.Qn + (size_t)qrow * A.ldq + d0 * 16 + hi * 8);
    LAS char* qx = lds + 2 * SHM_V + 2 * KBUF + 2048 + wid * 4608 + r32 * 144 + hi * 16;
    if constexpr (DQK == 192) {
#pragma unroll
        for (int d0 = 0; d0 < 4; ++d0) *(LAS bf16x8*)(qx + d0 * 32) = *(const bf16x8*)(A.Qr + (size_t)qrow * A.ldqr + d0 * 16 + hi * 8);
    }
    const int sr = tid >> 4, sc = (tid & 15) * 8, vst0 = v_st(sr, sc), vst1 = v_st(32 + sr, sc);
    const int vb0 = (int)(unsigned)(size_t)V_lds + v_rd_base(lane);
    const int ntiles = 4 * (qb + 1);
    float m_reg = -1e30f, l_reg = 0.f; f32x16 o[4];
#pragma unroll
    for (int d = 0; d < 4; ++d) o[d] = (f32x16){};
    bf16x8 stk[KPT], stv0, stv1;
#define ATT_LOADT(t, MW) do { const int key0_ = (t) * 64; \
        if constexpr (BITMASK) MW = *(const u32x2*)(A.mask + (size_t)qrow * 64 + 2 * (t));     \
        _Pragma("unroll") for (int i_ = 0; i_ < 2; ++i_) { const int id_ = tid + 512 * i_, row_ = id_ >> 4, c_ = id_ & 15; \
            stk[i_] = *(const bf16x8*)(A.Kn + (size_t)(key0_ + row_) * A.ldk + c_ * 8); } \
        if constexpr (DQK == 192) stk[KPT - 1] = *(const bf16x8*)(A.Kr + (size_t)(key0_ + (tid >> 3)) * A.ldkr + (tid & 7) * 8); \
        stv0 = *(const bf16x8*)(A.V + (size_t)(key0_ + sr) * A.ldv + sc); stv1 = *(const bf16x8*)(A.V + (size_t)(key0_ + 32 + sr) * A.ldv + sc); } while (0)
#define ATT_WRITET(buf) do { \
        _Pragma("unroll") for (int i_ = 0; i_ < 2; ++i_) { const int id_ = tid + 512 * i_, row_ = id_ >> 4, c_ = id_ & 15; \
            *(LAS bf16x8*)(K_lds + (buf) * KBUF + row_ * KROW + c_ * 16) = stk[i_]; } \
        if constexpr (DQK == 192) *(LAS bf16x8*)(K_lds + (buf) * KBUF + (tid >> 3) * KROW + 256 + (tid & 7) * 16) = stk[KPT - 1]; \
        *(LAS bf16x8*)(V_lds + (buf) * SHM_V + vst0) = stv0; *(LAS bf16x8*)(V_lds + (buf) * SHM_V + vst1) = stv1; } while (0)
#define ATT_SUB(t, BUF, SUBT) do { \
        f32x16 p0 = (f32x16){}; \
        const LAS char* kb_ = K_lds + (BUF) * KBUF + (SUBT) * 32 * KROW + r32 * KROW + hi * 16; \
        _Pragma("unroll") for (int d0 = 0; d0 < 8; ++d0) { const bf16x8 k0_ = *(const LAS bf16x8*)(kb_ + d0 * 32); \
            p0 = __builtin_amdgcn_mfma_f32_32x32x16_bf16(k0_, qr[d0], p0, 0, 0, 0); } \
        if constexpr (DQK == 192) { _Pragma("unroll") for (int d0 = 0; d0 < 4; ++d0) { const bf16x8 k0_ = *(const LAS bf16x8*)(kb_ + 256 + d0 * 32); const bf16x8 q_ = *(const LAS bf16x8*)(qx + d0 * 32); \
            p0 = __builtin_amdgcn_mfma_f32_32x32x16_bf16(k0_, q_, p0, 0, 0, 0); } } \
        const float NEG_ = -__builtin_inff(); \
        if constexpr (BITMASK) { const unsigned w0_ = ((SUBT) ? mw.y : mw.x) >> (4 * hi); \
            _Pragma("unroll") for (int r = 0; r < 16; ++r) { const int c_ = (r & 3) + 8 * (r >> 2); if (!((w0_ >> c_) & 1u)) p0[r] = NEG_; } } \
        else { if ((t) * 64 + (SUBT) * 32 + 31 > qlo) { const int dq_ = qrow - (t) * 64 - (SUBT) * 32 - 4 * hi; \
            _Pragma("unroll") for (int r = 0; r < 16; ++r) { const int c_ = (r & 3) + 8 * (r >> 2); if (c_ > dq_) p0[r] = NEG_; } } } \
        float pmax_ = p0[0]; \
        _Pragma("unroll") for (int r = 1; r < 16; ++r) pmax_ = fmaxf(pmax_, p0[r]); \
        { auto rr_ = __builtin_amdgcn_permlane32_swap(__float_as_uint(pmax_), __float_as_uint(pmax_), false, false); pmax_ = fmaxf(__uint_as_float(rr_[0]), __uint_as_float(rr_[1])); } \
        float mn_, alpha_; \
        if (__all((pmax_ - m_reg) * c2 <= 8.f)) { mn_ = m_reg; alpha_ = 1.f; } \
        else { mn_ = fmaxf(m_reg, pmax_); alpha_ = __builtin_amdgcn_exp2f((m_reg - mn_) * c2); m_reg = mn_; } \
        const float mnL_ = -mn_ * c2; \
        _Pragma("unroll") for (int r = 0; r < 16; ++r) p0[r] = __builtin_amdgcn_exp2f(fmaf(p0[r], c2, mnL_)); \
        float ps_ = 0.f; \
        _Pragma("unroll") for (int r = 0; r < 16; ++r) ps_ += p0[r]; \
        { auto rr_ = __builtin_amdgcn_permlane32_swap(__float_as_uint(ps_), __float_as_uint(ps_), false, false); ps_ = __uint_as_float(rr_[0]) + __uint_as_float(rr_[1]); } \
        l_reg = l_reg * alpha_ + ps_; \
        if (__any(alpha_ < 1.f)) { if (hi == 0) al_l[r32] = alpha_; asm volatile("s_waitcnt lgkmcnt(0)" ::: "memory"); \
            _Pragma("unroll") for (int d_ = 0; d_ < 4; ++d_) _Pragma("unroll") for (int r = 0; r < 16; ++r) o[d_][r] *= al_l[crow(r, hi)]; } \
        bf16x8 pa0, pa1; \
        ATT_PK4(p0, 0, pa0); ATT_PK4(p0, 8, pa1); \
        pv_half<BUF, SUBT>(o, vb0, pa0, pa1); } while (0)
#define ATT_COMPUTE(t, BUF, MW) do { if ((t) * 64 <= qlo + 31) { \
        const u32x2 mw = MW; \
        ATT_SUB(t, BUF, 0); \
        if ((t) * 64 + 32 <= qlo + 31) ATT_SUB(t, BUF, 1); } } while (0)
#define ATT_PK4(P, B_, OUT) do { const unsigned a0 = cvt_pk_bf16(P[B_ + 0], P[B_ + 1]), a1 = cvt_pk_bf16(P[B_ + 2], P[B_ + 3]); \
        const unsigned b0 = cvt_pk_bf16(P[B_ + 4], P[B_ + 5]), b1 = cvt_pk_bf16(P[B_ + 6], P[B_ + 7]); \
        auto r0 = __builtin_amdgcn_permlane32_swap(a0, b0, false, false); auto r1 = __builtin_amdgcn_permlane32_swap(a1, b1, false, false); \
        u32x4 w_ = {r0[0], r1[0], r0[1], r1[1]}; OUT = *reinterpret_cast<bf16x8*>(&w_); } while (0)
    u32x2 mwA = {0u, 0u}, mwB = {0u, 0u};
    ATT_LOADT(0, mwA); ATT_WRITET(0); __syncthreads();
    for (int t = 0; t < ntiles; t += 2) {
        ATT_LOADT(t + 1, mwB);
        ATT_COMPUTE(t, 0, mwA);
        ATT_WRITET(1);
        __syncthreads();
        if (t + 2 < ntiles) ATT_LOADT(t + 2, mwA);
        ATT_COMPUTE(t + 1, 1, mwB);
        if (t + 2 < ntiles) ATT_WRITET(0);
        __syncthreads();
    }
#undef ATT_LOADT
#undef ATT_WRITET
#undef ATT_COMPUTE
#undef ATT_PK4
    if (hi == 0) li_l[r32] = l_reg;
    asm volatile("s_waitcnt lgkmcnt(0)" ::: "memory");
    bf16_t* Ow = A.O + (size_t)qlo * A.ldo;
#pragma unroll
    for (int r = 0; r < 16; ++r) { const int orow = crow(r, hi); const float rl = __builtin_amdgcn_rcpf(li_l[orow]);
#pragma unroll
        for (int d0 = 0; d0 < 4; ++d0) { const float v = o[d0][r] * rl; const float vn = __shfl_xor(v, 1);
            if ((r32 & 1) == 0) *(unsigned*)(Ow + (size_t)orow * A.ldo + d0 * 32 + r32) = cvt_pk_bf16(v, vn); } }
    __syncthreads();
    __builtin_amdgcn_s_setprio(0);
}
}

__device__ __forceinline__ void moe_route_wg(const float* LOG, const float* SS, int npart, float* RSTD, const float* bg, const float* be, int* EID, float* WT, unsigned* HIST, int bx, int tid) {
    if (tid >= 64) return;
    const int lane = tid; const bool valid = lane < 32; const int tok = bx * 32 + (lane & 31);
    const float* lr = LOG + (size_t)tok * 64;
    float ssum = 0.f;
    for (int i = 0; i < npart; i += 4) { const f32x4 q = *(const f32x4*)(SS + (size_t)tok * 128 + i); ssum += (q[0] + q[1]) + (q[2] + q[3]); }
    const float rs = rsqrtf(ssum * (1.f / 4096.f) + 1e-6f);
    if (valid) RSTD[tok] = rs;
    float g[4]; float mx = -__builtin_inff();
#pragma unroll
    for (int j = 0; j < 4; ++j) { float s = 0.f;
#pragma unroll
        for (int sp = 0; sp < 8; ++sp) s += lr[(size_t)sp * T * 64 + 32 + j];
        g[j] = s * rs + bg[j]; mx = fmaxf(mx, g[j]); }
    float sum = 0.f; int gs = 0; float gb = g[0];
#pragma unroll
    for (int j = 0; j < 4; ++j) { sum += __expf(g[j] - mx); if (g[j] > gb) { gb = g[j]; gs = j; } }
    const float ggate = __expf(gb - mx) / sum;
    float e[8];
#pragma unroll
    for (int j = 0; j < 8; ++j) { float s = 0.f;
#pragma unroll
        for (int sp = 0; sp < 8; ++sp) s += lr[(size_t)sp * T * 64 + gs * 8 + j];
        e[j] = s * rs + be[gs * 8 + j]; }
    int i0 = 0; float v0 = e[0];
#pragma unroll
    for (int j = 1; j < 8; ++j) if (e[j] > v0) { v0 = e[j]; i0 = j; }
    int i1 = 0; float v1 = -__builtin_inff();
#pragma unroll
    for (int j = 0; j < 8; ++j) if (j != i0 && e[j] > v1) { v1 = e[j]; i1 = j; }
    const float p0 = 1.f, p1 = __expf(v1 - v0);
    const int e0 = gs * 8 + i0, e1 = gs * 8 + i1;
    if (valid) { EID[tok * 2] = e0; EID[tok * 2 + 1] = e1; WT[tok * 2] = ggate * p0 / (p0 + p1); WT[tok * 2 + 1] = ggate * p1 / (p0 + p1); }
    unsigned mine = 0u;
#pragma unroll 4
    for (int ee = 0; ee < NE; ++ee) {
        const unsigned c = (unsigned)__popcll(__ballot(valid && e0 == ee)) + (unsigned)__popcll(__ballot(valid && e1 == ee));
        if (lane == ee) mine = c;
    }
    if (valid) HIST[bx * 32 + lane] = mine;
}

__device__ __forceinline__ void moe_place_wg(LAS unsigned char* tab, const unsigned* HIST, const int* EID, const float* WT, unsigned* CNT, int* PROW, float* WROW,
                                             int bx, int G, int tid) {
    LAS int* rb = (LAS int*)tab;
    LAS int* posl = (LAS int*)tab + 64;
    const int lane = tid & 63;
    LAS int* red = (LAS int*)tab + 128;
    { const int e = tid & 31, wq = tid >> 5; int tot = 0, bef = 0;
#pragma unroll 4
      for (int w = wq; w < G; w += 16) { const int v = (int)HIST[w * 32 + e]; tot += v; bef += (w < bx) ? v : 0; }
      red[(wq * 32 + e) * 2] = tot; red[(wq * 32 + e) * 2 + 1] = bef; }
    __syncthreads();
    if (tid < 64) {
        const int e = lane & 31;
        int tot = 0, bef = 0;
#pragma unroll
        for (int wq = 0; wq < 16; ++wq) { tot += red[(wq * 32 + e) * 2]; bef += red[(wq * 32 + e) * 2 + 1]; }
        const int pad = ((tot + 255) >> 8) << 8;
        int base = 0;
#pragma unroll 4
        for (int j = 0; j < 32; ++j) { const int pj = __shfl(pad, j); base += (j < e) ? pj : 0; }
        if (lane < 32) { rb[e] = base + bef; if (bx == 0) CNT[e] = (unsigned)tot; if (bx == e) { posl[0] = base + tot; posl[1] = base + pad; } }
    }
    __syncthreads();
    if (bx < 32) { const int z0 = posl[0], z1 = posl[1]; for (int r = z0 + tid; r < z1; r += 512) st_wt(PROW + r, 0); }
    __syncthreads();
    if (tid < 64) {
        const bool valid = lane < 32; const int tok = bx * 32 + (lane & 31);
        const int e0 = EID[tok * 2], e1 = EID[tok * 2 + 1];
        int r0 = 0, r1 = 0;
#pragma unroll 4
        for (int tt = 0; tt < 32; ++tt) { const int a0 = __shfl(e0, tt), a1 = __shfl(e1, tt);
            if (tt < lane) { r0 += (a0 == e0) + (a1 == e0); r1 += (a0 == e1) + (a1 == e1); } }
        if (valid) { const int pos0 = rb[e0] + r0, pos1 = rb[e1] + r1;
            posl[2 * lane] = pos0; posl[2 * lane + 1] = pos1;
            st_wt(PROW + pos0, tok * 2); st_wt(PROW + pos1, tok * 2 + 1); st_wt(WROW + pos0, WT[tok * 2]); st_wt(WROW + pos1, WT[tok * 2 + 1]); }
    }
    __syncthreads();
}
__device__ __forceinline__ void combine_row(const bf16_t* xi, const bf16_t* y0, const bf16_t* y1, bf16_t* xo, const float* g, bf16_t* hn, float* fout, float* rs_out, int lane) {
    f32x4 v[16]; float s = 0.f;
#pragma unroll
    for (int j = 0; j < 16; ++j) { const u32x2 x = ((const u32x2*)xi)[lane + 64 * j], a = ((const u32x2*)y0)[lane + 64 * j], b = ((const u32x2*)y1)[lane + 64 * j];
        v[j].x = bf_lo(x.x) + bf_lo(a.x) + bf_lo(b.x); v[j].y = bf_hi(x.x) + bf_hi(a.x) + bf_hi(b.x); v[j].z = bf_lo(x.y) + bf_lo(a.y) + bf_lo(b.y); v[j].w = bf_hi(x.y) + bf_hi(a.y) + bf_hi(b.y);
        s += (v[j].x * v[j].x + v[j].y * v[j].y) + (v[j].z * v[j].z + v[j].w * v[j].w); }
    const float rstd = rsqrtf(wave_sum(s) * (1.f / 4096.f) + 1e-6f);
    if (rs_out) { if (lane == 0) st_wt(rs_out, rstd); }
    if (!hn && !fout) {
#pragma unroll
        for (int j = 0; j < 16; ++j) { u32x2 w; w.x = cvt_pk_bf16(v[j].x, v[j].y); w.y = cvt_pk_bf16(v[j].z, v[j].w); ((u32x2*)xo)[lane + 64 * j] = w; }
        return;
    }
#pragma unroll
    for (int j = 0; j < 16; ++j) { const f32x4 gg = ((const f32x4*)g)[lane + 64 * j];
        if (xo) { u32x2 w; w.x = cvt_pk_bf16(v[j].x, v[j].y); w.y = cvt_pk_bf16(v[j].z, v[j].w); ((u32x2*)xo)[lane + 64 * j] = w; }
        const f32x4 o = {v[j].x * rstd * gg.x, v[j].y * rstd * gg.y, v[j].z * rstd * gg.z, v[j].w * rstd * gg.w};
        if (hn) { u32x2 w; w.x = cvt_pk_bf16(o.x, o.y); w.y = cvt_pk_bf16(o.z, o.w); ((u32x2*)hn)[lane + 64 * j] = w; }
        if (fout) ((f32x4*)fout)[lane + 64 * j] = o; }
}

struct S5In { const float* lre; const float* lim; const float* logdt; const float* bre; const float* bim; const float* cre; const float* cim; const float* dsk; };
__device__ __forceinline__ void cmul(float ar, float ai, float br, float bi, float& cr, float& ci) { cr = ar * br - ai * bi; ci = ar * bi + ai * br; }
template <bool OUT>
__device__ __forceinline__ void s5_unit(LAS char* sl  , const S5In& W, const bf16_t* U, float* ELOC, bf16_t* YG, int b, int g, int ch, int lane) {
    const int n = lane & 31, hi = lane >> 5;
    float a1r[2], a1i[2], a2r[2], a2i[2], a3r[2], a3i[2], a4r[2], a4i[2];
    bf16x8 bfr[4];
    const float dt = __expf(W.logdt[g]);
#pragma unroll
    for (int X = 0; X < 2; ++X) {
        const int p = n + 32 * X, gi = g * S5P + p;
        const float lr = W.lre[gi], li = W.lim[gi];
        const float mag = __expf(lr * dt), ang = li * dt;
        const float are = mag * __cosf(ang), aim = mag * __sinf(ang);
        const float den = lr * lr + li * li, nr = are - 1.f;
        const float fre = (nr * lr + aim * li) / den, fim = (aim * lr - nr * li) / den;
        a1r[X] = are; a1i[X] = aim; cmul(are, aim, are, aim, a2r[X], a2i[X]); cmul(a2r[X], a2i[X], are, aim, a3r[X], a3i[X]); cmul(a2r[X], a2i[X], a2r[X], a2i[X], a4r[X], a4i[X]);
        const f32x4 br0 = *(const f32x4*)(W.bre + (size_t)gi * S5C + 8 * hi), br1 = *(const f32x4*)(W.bre + (size_t)gi * S5C + 8 * hi + 4);
        const f32x4 bi0 = *(const f32x4*)(W.bim + (size_t)gi * S5C + 8 * hi), bi1 = *(const f32x4*)(W.bim + (size_t)gi * S5C + 8 * hi + 4);
        const f32x4 re0 = br0 * fre - bi0 * fim, re1 = br1 * fre - bi1 * fim, im0 = bi0 * fre + br0 * fim, im1 = bi1 * fre + br1 * fim;
        u32x4 wr_ = {cvt_pk_bf16(re0[0], re0[1]), cvt_pk_bf16(re0[2], re0[3]), cvt_pk_bf16(re1[0], re1[1]), cvt_pk_bf16(re1[2], re1[3])};
        u32x4 wi_ = {cvt_pk_bf16(im0[0], im0[1]), cvt_pk_bf16(im0[2], im0[3]), cvt_pk_bf16(im1[0], im1[1]), cvt_pk_bf16(im1[2], im1[3])};
        bfr[2 * X] = *reinterpret_cast<bf16x8*>(&wr_); bfr[2 * X + 1] = *reinterpret_cast<bf16x8*>(&wi_);
    }
    float cr[2] = {0.f, 0.f}, ci[2] = {0.f, 0.f};
    if (OUT && ch > 0) {
#pragma unroll
        for (int X = 0; X < 2; ++X) {
            float pr = a4r[X], pi = a4i[X];
#pragma unroll
            for (int s = 0; s < 6; ++s) { float tr, ti; cmul(pr, pi, pr, pi, tr, ti); pr = tr; pi = ti; }
            const float* el = ELOC + (((size_t)(b * S5G + g) * 8) * S5P + n + 32 * X) * 2;
            for (int j = 0; j < ch; ++j) { const f32x2 e = *(const f32x2*)(el + (size_t)j * S5P * 2); float tr, ti; cmul(pr, pi, cr[X], ci[X], tr, ti); cr[X] = tr + e.x; ci[X] = ti + e.y; }
        }
    }
    bf16x8 cf[4]; f32x4 dsk4 = {0.f, 0.f, 0.f, 0.f};
    const int c16 = lane & 15, q4 = lane >> 4;
    if (OUT) {
#pragma unroll
        for (int ks = 0; ks < 4; ++ks) { const size_t ci_ = ((size_t)g * S5C + c16) * S5P + 16 * ks + 4 * q4;
            const f32x4 xr = *(const f32x4*)(W.cre + ci_), xi = *(const f32x4*)(W.cim + ci_);
            u32x4 w_ = {cvt_pk_bf16(xr[0], -xi[0]), cvt_pk_bf16(xr[1], -xi[1]), cvt_pk_bf16(xr[2], -xi[2]), cvt_pk_bf16(xr[3], -xi[3])};
            cf[ks] = *reinterpret_cast<bf16x8*>(&w_); }
        dsk4 = *(const f32x4*)(W.dsk + g * S5C + 4 * q4);
    }
    const size_t tokc = (size_t)b * SEQ + (size_t)ch * 256;
    bf16x8 ua_n = *(const bf16x8*)(U + (tokc + n) * S5W + g * S5C + 8 * hi);
    u32x2 uu_n0 = {0u, 0u}, uu_n1 = {0u, 0u};
    if (OUT) { uu_n0 = *(const u32x2*)(U + (tokc + c16) * S5W + g * S5C + 4 * q4); uu_n1 = *(const u32x2*)(U + (tokc + 16 + c16) * S5W + g * S5C + 4 * q4); }
#pragma unroll 1
    for (int tl = 0; tl < 8; ++tl) {
        const size_t tok0 = tokc + tl * 32;
        const bf16x8 ua = ua_n; const u32x2 uu_c0 = uu_n0, uu_c1 = uu_n1;
        if (tl + 1 < 8) { const size_t tk1 = tok0 + 32;
            ua_n = *(const bf16x8*)(U + (tk1 + n) * S5W + g * S5C + 8 * hi);
            if (OUT) { uu_n0 = *(const u32x2*)(U + (tk1 + c16) * S5W + g * S5C + 4 * q4); uu_n1 = *(const u32x2*)(U + (tk1 + 16 + c16) * S5W + g * S5C + 4 * q4); } }
        f32x16 acc[4];
#pragma unroll
        for (int k = 0; k < 4; ++k) acc[k] = __builtin_amdgcn_mfma_f32_32x32x16_bf16(ua, bfr[k], (f32x16){}, 0, 0, 0);
#pragma unroll
        for (int X = 0; X < 2; ++X) {
            f32x16& R = acc[2 * X]; f32x16& I = acc[2 * X + 1];
            const float ar = a1r[X], ai = a1i[X];
            float er[4], ei[4];
#pragma unroll
            for (int gq = 0; gq < 4; ++gq) {
#pragma unroll
                for (int k = 1; k < 4; ++k) { const int r = 4 * gq + k; const float pr = R[r - 1], pi = I[r - 1]; R[r] += ar * pr - ai * pi; I[r] += ar * pi + ai * pr; }
                er[gq] = R[4 * gq + 3]; ei[gq] = I[4 * gq + 3];
            }
            float mr[4], mi[4]; float c_r = cr[X], c_i = ci[X];
#pragma unroll
            for (int gq = 0; gq < 4; ++gq) {
                const float or_ = __shfl_xor(er[gq], 32), oi_ = __shfl_xor(ei[gq], 32);
                const float e0r = hi ? or_ : er[gq], e0i = hi ? oi_ : ei[gq];
                const float e1r = hi ? er[gq] : or_, e1i = hi ? ei[gq] : oi_;
                const float c0r = c_r, c0i = c_i; float tr, ti;
                cmul(a4r[X], a4i[X], c_r, c_i, tr, ti); c_r = tr + e0r; c_i = ti + e0i;
                const float c1r = c_r, c1i = c_i;
                cmul(a4r[X], a4i[X], c_r, c_i, tr, ti); c_r = tr + e1r; c_i = ti + e1i;
                mr[gq] = hi ? c1r : c0r; mi[gq] = hi ? c1i : c0i;
            }
            cr[X] = c_r; ci[X] = c_i;
            if (OUT) {
#pragma unroll
                for (int gq = 0; gq < 4; ++gq) {
                    float tr, ti;
                    cmul(a1r[X], a1i[X], mr[gq], mi[gq], tr, ti); R[4 * gq + 0] += tr; I[4 * gq + 0] += ti;
                    cmul(a2r[X], a2i[X], mr[gq], mi[gq], tr, ti); R[4 * gq + 1] += tr; I[4 * gq + 1] += ti;
                    cmul(a3r[X], a3i[X], mr[gq], mi[gq], tr, ti); R[4 * gq + 2] += tr; I[4 * gq + 2] += ti;
                    cmul(a4r[X], a4i[X], mr[gq], mi[gq], tr, ti); R[4 * gq + 3] += tr; I[4 * gq + 3] += ti;
                }
#pragma unroll
                for (int r = 0; r < 16; ++r) { const int row = (r & 3) + 8 * (r >> 2) + 4 * hi;
                    *(LAS unsigned*)(sl + row * 272 + X * 128 + n * 4) = cvt_pk_bf16(R[r], I[r]); }
            }
        }
        if (OUT) {
            asm volatile("s_waitcnt lgkmcnt(0)" ::: "memory");
#pragma unroll
            for (int hf = 0; hf < 2; ++hf) {
                f32x4 y = {0.f, 0.f, 0.f, 0.f};
#pragma unroll
                for (int ks = 0; ks < 4; ++ks) { const bf16x8 sf = *(const LAS bf16x8*)(sl + (16 * hf + c16) * 272 + (32 * ks + 8 * q4) * 2);
                    y = __builtin_amdgcn_mfma_f32_16x16x32_bf16(cf[ks], sf, y, 0, 0, 0); }
                const size_t tk = tok0 + 16 * hf + c16;
                const u32x2 uu = hf ? uu_c1 : uu_c0;
                y[0] += dsk4[0] * bf_lo(uu.x); y[1] += dsk4[1] * bf_hi(uu.x); y[2] += dsk4[2] * bf_lo(uu.y); y[3] += dsk4[3] * bf_hi(uu.y);
#pragma unroll
                for (int i = 0; i < 4; ++i) { const float z = 0.7978845608028654f * (y[i] + 0.044715f * y[i] * y[i] * y[i]); const float th = 1.f - 2.f / (1.f + __expf(2.f * z)); y[i] = 0.5f * y[i] * (1.f + th); }
                st_wt8(YG + tk * S5W + g * S5C + 4 * q4, cvt_pk_bf16(y[0], y[1]), cvt_pk_bf16(y[2], y[3]));
            }
            asm volatile("s_waitcnt lgkmcnt(0)" ::: "memory");
        }
    }
    if (!OUT && hi == 0) {
#pragma unroll
        for (int X = 0; X < 2; ++X) { f32x2 e = {cr[X], ci[X]}; *(f32x2*)(ELOC + (((size_t)(b * S5G + g) * 8 + ch) * S5P + n + 32 * X) * 2) = e; }
    }
}

struct MKArgs { const float* in[27]; float* out; unsigned char* ws; int ph_lo, ph_hi; };
constexpr int NPHASE = 21;

__global__ void __launch_bounds__(512, 2) mk_fwd(MKArgs args) {
    extern __shared__ __attribute__((aligned(16))) unsigned char lds_raw[];
    LAS unsigned char* lds = (LAS unsigned char*)lds_raw;
    const int tid = threadIdx.x, lane = tid & 63, wave = __builtin_amdgcn_readfirstlane(tid >> 6);
    const int G = gridDim.x, bx = blockIdx.x;
    const int gw = bx * 8 + wave, NGW = G * 8;
    volatile LAS unsigned* MISC = (volatile LAS unsigned*)(lds + MISC_OFF);
    if (tid < 32) MISC[tid] = 0u;
    __syncthreads();
    unsigned char* ws = args.ws;
    const int lo = args.ph_lo, hi = args.ph_hi;
    XcdBarrier bar; bar.bar = (unsigned*)(ws + F_CTL) + CW_BAR; bar.x = 0; bar.st = MISC + 8;
    if (hi - lo > 1) bar = xcd_barrier_post((unsigned*)(ws + F_CTL) + CW_BAR, MISC + 8);
#ifndef PHMASK
#define PHMASK 0xffffffffu
#endif
#define IN(k) (((PHMASK >> (k)) & 1u) && lo <= (k) && (k) < hi)
#define SEAM(k) do { if (IN(k) && IN((k) + 1)) xcd_barrier(bar); } while (0)
    constexpr size_t HNS = (size_t)T * 4096;
#define x_in ((const float*)args.in[0])
#define positions ((const int*)args.in[1])
#define norm_mix ((const float*)args.in[2])
#define norm_ffn ((const float*)args.in[3])
#define norm_final ((const float*)args.in[4])
#define BT1 ((bf16_t*)(ws + F_BT1))
#define BT2A ((bf16_t*)(ws + F_BT2A))
#define BT2B ((bf16_t*)(ws + F_BT2B))
#define BT3 ((bf16_t*)(ws + F_BT3))
#define BT4 ((bf16_t*)(ws + F_BT4))
#define BT5 ((bf16_t*)(ws + F_BT5))
#define BTR ((bf16_t*)(ws + F_BTR))
#define BTGU ((bf16_t*)(ws + F_BTGU))
#define BTDN ((bf16_t*)(ws + F_BTDN))
#define HN ((bf16_t*)(ws + F_HN))
#define P ((bf16_t*)(ws + F_P))
#define STQ ((float*)(ws + F_STQ))
#define STKV ((float*)(ws + F_STKV))
#define MASK ((unsigned*)(ws + F_MASK))
#define Q ((bf16_t*)(ws + F_Q))
#define KV ((bf16_t*)(ws + F_KV))
#define CC ((bf16_t*)(ws + F_CC))
#define XBH ((bf16_t*)(ws + F_XB))
#define LOG ((float*)(ws + F_LOG))
#define EID ((int*)(ws + F_EID))
#define WT ((float*)(ws + F_WT))
#define HIST ((unsigned*)(ws + F_HIST))
#define CNT ((unsigned*)(ws + F_CNT))
#define PROW ((int*)(ws + F_PROW))
#define WROW ((float*)(ws + F_WROW))
#define ACT ((bf16_t*)(ws + F_ACT))
#define Y ((bf16_t*)(ws + F_Y))
#define SS ((float*)(ws + F_SS))
#define RSTD ((float*)(ws + F_RSTD))
#define U ((bf16_t*)(ws + F_U))
#define YG ((bf16_t*)(ws + F_YG))
#define ELOC ((float*)(ws + F_ELOC))

#define MOE_CONV(L, I0, I1) MOE_CONV_X(L, I0, I1, gw, NGW)
#define MOE_CONV_X(L, I0, I1, GW_, NGW_) do { for (int id_ = (I0) + (GW_); id_ < (I1); id_ += 4 * (NGW_)) moe_conv4(args.in[25], args.in[26], BTGU, BTDN, norm_ffn + (L) * 4096, (L), id_, (NGW_), (I1), lane); } while (0)
    if (IN(0)) {
        tr_matrix(args.in[5], 4096, PW, BT1, norm_mix, gw, NGW, lane, MapG1{});
        for (int i = gw * 64 + lane; i < (PWF - PW) * 4096 / 8; i += NGW * 64) ((u32x4*)(BT1 + (size_t)PW * 4096))[i] = (u32x4){0u, 0u, 0u, 0u};
        tr_matrix(args.in[8], 1024, 3072, BT2A, args.in[6], gw, NGW, lane, MapUQ{});
        tr_matrix(args.in[9], 512, 4096, BT2B, args.in[7], gw, NGW, lane, MapUKV{});
        tr_matrix(args.in[10], 4096, 4096, BT3, nullptr, gw, NGW, lane, MapId{});
        tr_matrix(args.in[11], 4096, 2048, BT4, norm_mix + 4096, gw, NGW, lane, MapId{});
        tr_matrix(args.in[20], 2048, 8192, BT5, nullptr, gw, NGW, lane, MapPair{4096});
        for (int l = 0; l < 2; ++l) {
            bf16_t* br = BTR + (size_t)l * 256 * 4096;
            for (int i = gw * 64 + lane; i < (256 - 36) * 4096 / 8; i += NGW * 64) ((u32x4*)(br + (size_t)36 * 4096))[i] = (u32x4){0u, 0u, 0u, 0u};
            tr_matrix(args.in[23] + (size_t)l * 4096 * 32, 4096, 32, br, norm_ffn + l * 4096, gw, NGW, lane, MapId{});
            tr_matrix(args.in[21] + (size_t)l * 4096 * 4, 4096, 4, br, norm_ffn + l * 4096, gw, NGW, lane, MapOff{32});
        }
        for (int m = gw; m < T; m += NGW) cast_row_bf16(x_in + (size_t)m * 4096, HN + (size_t)m * 4096, (float*)(ws + F_RS1) + m, lane);
    }
    SEAM(0);
    if (IN(1)) {
        pg::PlainSched S; S.init(HN, 4096 * 2, BT1, 4096, T, PWF, G, bx);
        EpiG1 E{P, STQ, STKV, positions, (const float*)(ws + F_RS1)};
        pg::gemm_phase(lds, 4096, (size_t)4096 * 2, S, E);
        if (G == 256) { if (bx >= 224) MOE_CONV_X(0, 0, 8192, (bx - 224) * 8 + wave, 256); } else MOE_CONV(0, 0, 8192);
    }
    SEAM(1);
    if (IN(2)) {
        { pg::PlainSched S; S.init(P + FC_CQ, PWF * 2, BT2A, 1024, T, 3072, G, bx);
          EpiNormed<16, 1024, 8> E{Q, 3072, STQ, positions};
          pg::gemm_phase(lds, 1024, (size_t)PWF * 2, S, E); }
        { pg::PlainSched S; S.init(P + FC_CKV, PWF * 2, BT2B, 512, T, 4096, G, bx);
          if (G == 256) { if (bx < 128) S.deal(bx, 256, 1); else S.deal(bx, 128, 3); }
          EpiNormed<8, 512, 1000> E{KV, 4096, STKV, positions};
          pg::gemm_phase(lds, 512, (size_t)PWF * 2, S, E); }
        if (wave & 1) MOE_CONV(0, 8192, 32768);
        for (int u = gw; u < 2048; u += NGW) {
            indexer_unit(P, MASK, u >> 10, u & 1023, lane);
            const int u2 = 4095 - u; indexer_unit(P, MASK, u2 >> 10, u2 & 1023, lane);
        }
        if (!(wave & 1)) MOE_CONV(0, 8192, 32768);
    }
    SEAM(2);
    if (IN(3)) {
        for (int it = bx; it < 256; it += G) {
            const int bh = it >> 2, b = bh >> 4, h = bh & 15, xq = it & 3;
            const size_t t0 = (size_t)b * SEQ;
            att::AttPtrs A;
            A.Qn = P + t0 * PWF + FC_QA + h * 128; A.ldq = PWF; A.Qr = nullptr; A.ldqr = 0;
            A.Kn = P + t0 * PWF + FC_KA + (h >> 2) * 128; A.ldk = PWF; A.Kr = nullptr; A.ldkr = 0;
            A.V = P + t0 * PWF + FC_VA + (h >> 2) * 128; A.ldv = PWF; A.O = CC + t0 * 4096 + h * 128; A.ldo = 4096;
            A.mask = MASK + t0 * 64; A.c2 = 0.12751743f;
            if ((bx & 3) == 0) MOE_CONV(0, 32768, 98304);
            att::attn_qblock<128, true>((LAS char*)lds, A, xq);
            if ((bx & 3) == 1) MOE_CONV(0, 32768, 98304);
            att::attn_qblock<128, true>((LAS char*)lds, A, 7 - xq);
        }
        for (int it = bx; it < 256; it += G) {
            const int bh = it >> 2, b = bh >> 4, h = bh & 15, xq = it & 3;
            const size_t t0 = (size_t)b * SEQ;
            att::AttPtrs A;
            A.Qn = Q + t0 * 3072 + h * 128; A.ldq = 3072; A.Qr = Q + t0 * 3072 + 2048 + h * 64; A.ldqr = 3072;
            A.Kn = KV + t0 * 4096 + h * 128; A.ldk = 4096; A.Kr = P + t0 * PWF + FC_KR; A.ldkr = PWF;
            A.V = KV + t0 * 4096 + 2048 + h * 128; A.ldv = 4096; A.O = CC + t0 * 4096 + 2048 + h * 128; A.ldo = 4096;
            A.mask = nullptr; A.c2 = 0.10411707f;
            if ((bx & 3) == 2) MOE_CONV(0, 32768, 98304);
            att::attn_qblock<192, false>((LAS char*)lds, A, xq);
            if ((bx & 3) == 3) MOE_CONV(0, 32768, 98304);
            att::attn_qblock<192, false>((LAS char*)lds, A, 7 - xq);
        }
    }
    SEAM(3);
    if (IN(4)) {
        pg::PlainSched S; S.init(CC, 4096 * 2, BT3, 4096, T, 4096, G, bx);
        EpiRes E{HN, HN + 1 * HNS, SS};
        pg::gemm_phase(lds, 4096, (size_t)4096 * 2, S, E);
    }
    SEAM(4);

#define EARLYQ 4
#define MOE_EARLY(totg, u1dn) int ni_ = ((totg) > G && (totg) < 2 * G) ? 2 * G - (totg) : 0; if (ni_ < 32) ni_ = 0; int ne_ = ni_ * EARLYQ; if (ne_ > (u1dn) || ne_ > 4 * G) { ni_ = 0; ne_ = 0; }
#define MOE_BLOCK(PB, L, NPART, XIN, XOUT, GNEXT, FINAL) do { \
    bf16_t* const HNL = HN + 1 * HNS; float* const LOGL = LOG + (size_t)(L) * 8 * T * 64; float* const SSL = SS + (size_t)(L) * T * 128; float* const RSTDL = RSTD + (size_t)(L) * T; \
    int* const EIDL = EID + (size_t)(L) * NPAIR; float* const WTL = WT + (size_t)(L) * NPAIR; unsigned* const HISTL = HIST + (L) * 256 * 32; unsigned* const CNTL = CNT + (L) * 1024; \
    int* const PROWL = PROW + (size_t)(L) * MAXROWS; float* const WROWL = WROW + (size_t)(L) * MAXROWS; bf16_t* const ACTL = ACT + (size_t)(L) * MAXROWS * 512; bf16_t* const YL = Y; unsigned* const TCL = (unsigned*)(ws + F_CTL + 65536) + (L) * 4096;     \
    if (IN((PB) + 0)) { pg::RouterSched S; S.A = (const char*)HNL; S.B = (const char*)(BTR + (size_t)(L) * 256 * 4096); S.G = G; S.c = bx; EpiLogits E{LOGL}; pg::gemm_phase(lds, 512, (size_t)4096 * 2, S, E, (size_t)4096 * 2); } \
    SEAM((PB) + 0); \
    if (IN((PB) + 1)) { moe_route_wg(LOGL, SSL, (NPART), RSTDL, args.in[22] + (L) * 4, args.in[24] + (L) * 32, EIDL, WTL, HISTL, bx, tid); } \
    SEAM((PB) + 1); \
    if (IN((PB) + 2)) { moe_place_wg(lds + TAB_OFF, HISTL, EIDL, WTL, CNTL, PROWL, WROWL, bx, G, tid); } \
    SEAM((PB) + 2); \
    if (IN((PB) + 3)) { pg::MoeSched S; S.A = (const char*)HNL; S.B = (const char*)(BTGU + (size_t)(L) * 32 * 1024 * 4096); S.cnt = CNTL; S.ldaB = 8192; S.tstepB = (size_t)256 * 4096 * 2; S.bexp = (size_t)1024 * 4096 * 2; S.NT = 4; S.ntsh = 2; S.G = G; S.c = bx; S.gather = 1; S.first = bx; S.step = G; S.lim = 1 << 30; S.load_counts(lds); \
        EpiSilu E{ACTL, PROWL, RSTDL, TCL}; pg::gemm_phase<EpiSilu, pg::MoeSched, true, true>(lds, 4096, (size_t)8192, S, E, 0, PROWL); \
          \
        { const int totg_ = S.total(), u1d_ = 4 * S.u1(); MOE_EARLY(totg_, u1d_); \
          if (ni_ > 0 && bx >= G - ni_) { \
            __syncthreads(); \
            pg::MoeSched S2; S2.A = (const char*)ACTL; S2.B = (const char*)(BTDN + (size_t)(L) * 32 * 4096 * 512); S2.cnt = CNTL; S2.ldaB = 1024; S2.tstepB = (size_t)256 * 512 * 2; S2.bexp = (size_t)4096 * 512 * 2; S2.NT = 16; S2.ntsh = 4; S2.G = G; S2.c = bx; S2.gather = 0; \
            S2.first = bx - (G - ni_); S2.step = ni_; S2.lim = EARLYQ; S2.load_counts(lds); \
            for (int k_ = 0; k_ < EARLYQ; ++k_) { pg::GUnit uu_; const bool ok_ = S2.next(k_, uu_); \
                if (ok_ && tid == 0) { unsigned sp_ = 0; while (xb_ld(TCL + uu_.pm * 32) < 32u) { __builtin_amdgcn_s_sleep(1); if ((++sp_ & 255u) == 0u && (xb_ld(&bar.bar[XB_TMO]) || sp_ > XB_SPIN_CAP)) break; } } } \
            if (tid == 0) { __builtin_amdgcn_fence(__ATOMIC_ACQUIRE, "agent"); asm volatile("s_waitcnt vmcnt(0)" ::: "memory"); } \
            __syncthreads(); \
            EpiDown E2{YL, PROWL, WROWL}; pg::gemm_phase<EpiDown, pg::MoeSched, false, true>(lds, 512, (size_t)1024, S2, E2); } } } \
    SEAM((PB) + 3); \
    if (IN((PB) + 4)) { pg::MoeSched S; S.A = (const char*)ACTL; S.B = (const char*)(BTDN + (size_t)(L) * 32 * 4096 * 512); S.cnt = CNTL; S.ldaB = 1024; S.tstepB = (size_t)256 * 512 * 2; S.bexp = (size_t)4096 * 512 * 2; S.NT = 16; S.ntsh = 4; S.G = G; S.c = bx; S.gather = 0; S.first = bx; S.step = G; S.lim = 1 << 30; S.load_counts(lds); \
        { const int totg_ = S.total() >> 2, u1d_ = S.u1(); MOE_EARLY(totg_, u1d_); S.first = ne_ + bx; }     \
        EpiDown E{YL, PROWL, WROWL}; pg::gemm_phase<EpiDown, pg::MoeSched, false, true>(lds, 512, (size_t)1024, S, E); } \
    SEAM((PB) + 4); \
    if (IN((PB) + 5)) { for (int m = gw; m < T; m += NGW) combine_row((XIN) + (size_t)m * 4096, YL + (size_t)(2 * m) * 4096, YL + (size_t)(2 * m + 1) * 4096, (FINAL) ? nullptr : (XOUT) + (size_t)m * 4096, (GNEXT), \
                                                                    nullptr, (FINAL) ? args.out + (size_t)m * 4096 : nullptr, (FINAL) ? nullptr : (float*)(ws + F_RS4) + m, lane); } \
    SEAM((PB) + 5); } while (0)

    MOE_BLOCK(5, 0, 64, HN + 1 * HNS, XBH, norm_mix + 4096, false);
    if (IN(11)) { pg::PlainSched S; S.init(XBH, 4096 * 2, BT4, 4096, T, 2048, G, bx); EpiBf16R E{U, 2048, (const float*)(ws + F_RS4)}; pg::gemm_phase(lds, 4096, (size_t)4096 * 2, S, E); }
    SEAM(11);
    { S5In W{args.in[12], args.in[13], args.in[14], args.in[15], args.in[16], args.in[17], args.in[18], args.in[19]};
      if (IN(12)) { if (wave & 1) MOE_CONV(1, 0, 32768);
        for (int u = gw; u < 4096; u += NGW) { const int ch = u & 7; if (ch < 7) s5_unit<false>((LAS char*)lds + wave * 8704, W, U, ELOC, YG, u >> 10, (u >> 3) & 127, ch, lane); }
        if (!(wave & 1)) MOE_CONV(1, 0, 32768); }
      SEAM(12);
      if (IN(13)) { if (wave & 1) MOE_CONV(1, 32768, 98304);
        for (int u = gw; u < 4096; u += NGW) s5_unit<true>((LAS char*)lds + wave * 8704, W, U, ELOC, YG, u >> 10, (u >> 3) & 127, u & 7, lane);
        if (!(wave & 1)) MOE_CONV(1, 32768, 98304); }
      SEAM(13); }
    if (IN(14)) { pg::PlainSched S; S.init(YG, 2048 * 2, BT5, 2048, T, 8192, G, bx); EpiGlu E{XBH, HN + 1 * HNS, SS + (size_t)T * 128}; pg::gemm_phase(lds, 2048, (size_t)2048 * 2, S, E); }
    SEAM(14);
    MOE_BLOCK(15, 1, 128, HN + 1 * HNS, XBH, norm_final, true);
#undef MOE_BLOCK
#undef MOE_CONV
#undef x_in
#undef positions
#undef norm_mix
#undef norm_ffn
#undef norm_final
#undef BT1
#undef BT2A
#undef BT2B
#undef BT3
#undef BT4
#undef BT5
#undef BTR
#undef BTGU
#undef BTDN
#undef HN
#undef P
#undef STQ
#undef STKV
#undef MASK
#undef Q
#undef KV
#undef CC
#undef XBH
#undef LOG
#undef EID
#undef WT
#undef HIST
#undef CNT
#undef PROW
#undef WROW
#undef ACT
#undef Y
#undef SS
#undef RSTD
#undef U
#undef YG
#undef ELOC
#undef IN
#undef SEAM
}

#if MODE == 1
struct ViewP { const void* fast; float* orc; double* part; long ldf, ldo; int rows, cols, map, fbf16, inject, fcol0, pad; };
__device__ __forceinline__ int view_map(int map, int c) {
    switch (map) {
        case 1: return MapG1{}(c);
        case 2: return (c < 32) ? 2 * c : 2 * (c - 32) + 1;
        case 3: return MapUQ{}(c);
        case 4: return MapUKV{}(c);
        default: return c;
    }
}
__global__ __launch_bounds__(256) void k_view(ViewP v) {
    __shared__ double shn[256], shd[256];
    double num = 0.0, den = 0.0;
    const long total = (long)v.rows * v.cols;
    for (long i = (long)blockIdx.x * 256 + threadIdx.x; i < total; i += (long)gridDim.x * 256) {
        const long r = i / v.cols; const int c = (int)(i % v.cols);
        const long fo = r * v.ldf + v.fcol0 + view_map(v.map, c);
        const float o = v.orc[r * v.ldo + c];
        if (v.inject) { if (v.fbf16) ((bf16_t*)v.fast)[fo] = (bf16_t)(cvt_pk_bf16(o, 0.f) & 0xffffu); else ((float*)v.fast)[fo] = o; }
        else { const float f = v.fbf16 ? __uint_as_float(((unsigned)((const bf16_t*)v.fast)[fo]) << 16) : ((const float*)v.fast)[fo];
            const double d = (double)f - (double)o; num += d * d; den += (double)o * (double)o; if (!(f == f)) num += 1e30; }
    }
    if (!v.inject) {
        shn[threadIdx.x] = num; shd[threadIdx.x] = den; __syncthreads();
        for (int s = 128; s > 0; s >>= 1) { if (threadIdx.x < s) { shn[threadIdx.x] += shn[threadIdx.x + s]; shd[threadIdx.x] += shd[threadIdx.x + s]; } __syncthreads(); }
        if (threadIdx.x == 0) { v.part[blockIdx.x * 2] = shn[0]; v.part[blockIdx.x * 2 + 1] = shd[0]; }
    }
}
__global__ __launch_bounds__(256) void k_view_mask(unsigned* mask, const unsigned char* sel, double* part, int inject) {
    __shared__ double shn[256], shd[256];
    double num = 0.0, den = 0.0;
    const long total = (long)T * 64;
    for (long i = (long)blockIdx.x * 256 + threadIdx.x; i < total; i += (long)gridDim.x * 256) {
        const long row = i >> 6; const int wd = (int)(i & 63);
        unsigned m = 0u;
        for (int bit = 0; bit < 32; ++bit) m |= (sel[row * SEQ + wd * 32 + bit] ? 1u : 0u) << bit;
        if (inject) mask[i] = m; else { num += (double)__popc(m ^ mask[i]); den += (double)__popc(m); }
    }
    if (!inject) {
        shn[threadIdx.x] = num; shd[threadIdx.x] = den; __syncthreads();
        for (int s = 128; s > 0; s >>= 1) { if (threadIdx.x < s) { shn[threadIdx.x] += shn[threadIdx.x + s]; shd[threadIdx.x] += shd[threadIdx.x + s]; } __syncthreads(); }
        if (threadIdx.x == 0) { part[blockIdx.x * 2] = shn[0]; part[blockIdx.x * 2 + 1] = shd[0]; }
    }
}
constexpr int VIEW_BLOCKS = 1024, MAX_SEAMS = 32;
__device__ __forceinline__ void d_encode(const double* part, int nseams, const float* tol, float* code) {
    if (threadIdx.x != 0 || blockIdx.x != 0) return;
    int k1 = 0, k2 = 0, nact = 0; double e1 = 0.0;
    for (int s = 0; s < nseams; ++s) {
        double num = 0.0, den = 0.0;
        for (int b = 0; b < VIEW_BLOCKS; ++b) { num += part[((long)s * VIEW_BLOCKS + b) * 2]; den += part[((long)s * VIEW_BLOCKS + b) * 2 + 1]; }
        if (!(den > 0.0)) { if (num > 0.0) den = 1e-30; else continue; }
        const double e = num / den; ++nact;
        if (!(e <= (double)tol[s])) { if (k1 == 0) { k1 = s + 1; e1 = e; } else if (k2 == 0) k2 = s + 1; }
    }
    const int mag = (e1 < 1e-3) ? 0 : (e1 < 1e-2) ? 1 : (e1 < 1e-1) ? 2 : 3;
    code[0] = 1.0f + 0.01f * (float)k1;
    code[1] = (k1 == 0) ? (float)nact : (float)(4 * k2 + mag);
}
__global__ void k_apply_code(float* out, const float* code, long n) {
    const float sc = code[0];
    for (long i = (long)blockIdx.x * blockDim.x + threadIdx.x; i < n; i += (long)gridDim.x * blockDim.x) { float v = out[i] * sc; if (i == 0) v += code[1]; out[i] = v; }
}
#endif


extern "C" void kernel_launch(void* const* d_in, const int* in_sizes, int n_in, void* d_out, int out_size, void* d_ws, size_t ws_size, hipStream_t stream) {
    static int inited = 0;
    if (!inited) {
        if (n_in != 27 || (size_t)F_END > ws_size) { fprintf(stderr, "kernel_launch: unexpected n_in %d or workspace %zu < %zu\n", n_in, ws_size, (size_t)F_END); inited = -1; return; }
        if (hipFuncSetAttribute((const void*)mk_fwd, hipFuncAttributeMaxDynamicSharedMemorySize, LDS_BYTES) != hipSuccess) { fprintf(stderr, "kernel_launch: hipFuncSetAttribute failed\n"); inited = -1; return; }
        inited = 1;
    }
    if (inited < 0) return;
    (void)in_sizes; (void)out_size;
    (void)hipMemsetAsync((char*)d_ws + F_CTL, 0, F_CTL_B, stream);
    MKArgs a{};
    for (int i = 0; i < 27; ++i) a.in[i] = (const float*)d_in[i];
    a.out = (float*)d_out; a.ws = (unsigned char*)d_ws; a.ph_lo = 0; a.ph_hi = NPHASE;
    hipLaunchKernelGGL(mk_fwd, dim3(256), dim3(512), LDS_BYTES, stream, a);
}
```

```cpp
#define MODE 2
#include <hip/hip_runtime.h>
#include <stdint.h>
#include <stdio.h>

constexpr int DM = 4096, NB = 4, SEQ = 2048, T = NB * SEQ;
constexpr int PW = 5776;
constexpr int OFF_QA = 0, OFF_KA = 2048, OFF_VA = 2560, OFF_IQ = 3072, OFF_IK = 4096, OFF_IW = 4160, OFF_CQ = 4176, OFF_CKV = 5200, OFF_KR = 5712;
constexpr int NSEL = 256;
constexpr int S5W = 2048, S5G = 128, S5P = 64, S5C = 16;
constexpr int NE = 32, NGRP = 4, EPG = 8, FF = 512, NPAIR = T * 2;


#define GAS __attribute__((address_space(1)))
#define LAS __attribute__((address_space(3)))
typedef unsigned short bf16_t;
typedef short bf16x8 __attribute__((ext_vector_type(8)));
typedef short s16x4 __attribute__((ext_vector_type(4)));
typedef float f32x2 __attribute__((ext_vector_type(2)));
typedef float f32x4 __attribute__((ext_vector_type(4)));
typedef float f32x16 __attribute__((ext_vector_type(16)));
typedef unsigned u32x2 __attribute__((ext_vector_type(2)));
typedef unsigned u32x4 __attribute__((ext_vector_type(4)));
typedef int i32x4 __attribute__((ext_vector_type(4)));
typedef GAS unsigned gu32;
#define RLX_AGENT __ATOMIC_RELAXED, __HIP_MEMORY_SCOPE_AGENT

typedef __bf16 bf16x2_hw __attribute__((ext_vector_type(2)));
__device__ __forceinline__ unsigned cvt_pk_bf16(float lo, float hi) { const f32x2 v = {lo, hi}; const bf16x2_hw b = __builtin_convertvector(v, bf16x2_hw); return __builtin_bit_cast(unsigned, b); }
__device__ __forceinline__ float bf_lo(unsigned w) { return __uint_as_float(w << 16); }
__device__ __forceinline__ float bf_hi(unsigned w) { return __uint_as_float(w & 0xffff0000u); }
__device__ __forceinline__ void st_wt(unsigned* p, unsigned v) { __hip_atomic_store(p, v, __ATOMIC_RELAXED, __HIP_MEMORY_SCOPE_AGENT); }
__device__ __forceinline__ void st_wt(int* p, int v) { __hip_atomic_store(p, v, __ATOMIC_RELAXED, __HIP_MEMORY_SCOPE_AGENT); }
__device__ __forceinline__ void st_wt(float* p, float v) { __hip_atomic_store((unsigned*)p, __float_as_uint(v), __ATOMIC_RELAXED, __HIP_MEMORY_SCOPE_AGENT); }
__device__ __forceinline__ void st_wt8(void* p, unsigned lo, unsigned hi) { __hip_atomic_store((unsigned long long*)p, ((unsigned long long)hi << 32) | lo, __ATOMIC_RELAXED, __HIP_MEMORY_SCOPE_AGENT); }
__device__ __forceinline__ float wave_sum(float v) {
#pragma unroll
    for (int o = 1; o < 64; o <<= 1) v += __shfl_xor(v, o);
    return v;
}

constexpr int PWF = 5888;
constexpr int FC_QA = 0, FC_KA = 2048, FC_VA = 2560, FC_IQ = 3072, FC_CQ = 4096, FC_CKV = 5120, FC_IK = 5632, FC_KR = 5696, FC_IW = 5760;
constexpr int MAXROWS = 24576;
constexpr size_t alz(size_t x) { return (x + 4095) & ~(size_t)4095; }
constexpr size_t F_CTL = 0, F_CTL_B = (size_t)1 << 20;
constexpr size_t F_BT1 = F_CTL + F_CTL_B;                     constexpr size_t F_BT1_B = alz((size_t)PWF * 4096 * 2);
constexpr size_t F_BT2A = F_BT1 + F_BT1_B;                    constexpr size_t F_BT2A_B = alz((size_t)3072 * 1024 * 2);
constexpr size_t F_BT2B = F_BT2A + F_BT2A_B;                  constexpr size_t F_BT2B_B = alz((size_t)4096 * 512 * 2);
constexpr size_t F_BT3 = F_BT2B + F_BT2B_B;                   constexpr size_t F_BT3_B = alz((size_t)4096 * 4096 * 2);
constexpr size_t F_BT4 = F_BT3 + F_BT3_B;                     constexpr size_t F_BT4_B = alz((size_t)2048 * 4096 * 2);
constexpr size_t F_BT5 = F_BT4 + F_BT4_B;                     constexpr size_t F_BT5_B = alz((size_t)8192 * 2048 * 2);
constexpr size_t F_BTR = F_BT5 + F_BT5_B;                     constexpr size_t F_BTR_B = alz((size_t)2 * 256 * 4096 * 2);
constexpr size_t F_BTGU = F_BTR + F_BTR_B;                    constexpr size_t F_BTGU_B = alz((size_t)2 * 32 * 1024 * 4096 * 2);
constexpr size_t F_BTDN = F_BTGU + F_BTGU_B;                  constexpr size_t F_BTDN_B = alz((size_t)2 * 32 * 4096 * 512 * 2);
constexpr size_t F_HN = F_BTDN + F_BTDN_B;                    constexpr size_t F_HN_B = 2 * alz((size_t)T * 4096 * 2);
constexpr size_t F_P = F_HN + F_HN_B;                         constexpr size_t F_P_B = alz((size_t)T * PWF * 2);
constexpr size_t F_STQ = F_P + F_P_B;                         constexpr size_t F_STQ_B = alz((size_t)T * 16 * 4);
constexpr size_t F_STKV = F_STQ + F_STQ_B;                    constexpr size_t F_STKV_B = alz((size_t)T * 8 * 4);
constexpr size_t F_MASK = F_STKV + F_STKV_B;                  constexpr size_t F_MASK_B = alz((size_t)T * 64 * 4);
constexpr size_t F_Q = F_MASK + F_MASK_B;                     constexpr size_t F_Q_B = alz((size_t)T * 3072 * 2);
constexpr size_t F_KV = F_Q + F_Q_B;                          constexpr size_t F_KV_B = alz((size_t)T * 4096 * 2);
constexpr size_t F_CC = F_KV + F_KV_B;                        constexpr size_t F_CC_B = alz((size_t)T * 4096 * 2);
constexpr size_t F_XA = F_CC + F_CC_B;                        constexpr size_t F_XA_B = alz((size_t)T * 4096 * 4);
constexpr size_t F_XB = F_XA + F_XA_B;                        constexpr size_t F_XB_B = alz((size_t)T * 4096 * 4);
constexpr size_t F_LOG = F_XB + F_XB_B;                       constexpr size_t F_LOG_B = 2 * alz((size_t)8 * T * 64 * 4);
constexpr size_t F_EID = F_LOG + F_LOG_B;                     constexpr size_t F_EID_B = 2 * alz((size_t)NPAIR * 4);
constexpr size_t F_WT = F_EID + F_EID_B;                      constexpr size_t F_WT_B = 2 * alz((size_t)NPAIR * 4);
constexpr size_t F_HIST = F_WT + F_WT_B;                      constexpr size_t F_HIST_B = 2 * alz((size_t)256 * 32 * 4);
constexpr size_t F_CNT = F_HIST + F_HIST_B;                   constexpr size_t F_CNT_B = 2 * 4096;
constexpr size_t F_PROW = F_CNT + F_CNT_B;                    constexpr size_t F_PROW_B = 2 * alz((size_t)MAXROWS * 4);
constexpr size_t F_WROW = F_PROW + F_PROW_B;                  constexpr size_t F_WROW_B = 2 * alz((size_t)MAXROWS * 4);
constexpr size_t F_AG = F_WROW + F_WROW_B;                    constexpr size_t F_AG_B = 4096;
constexpr size_t F_ACT = F_AG + F_AG_B;                       constexpr size_t F_ACT_B = 2 * alz((size_t)MAXROWS * 512 * 2);
constexpr size_t F_Y = F_ACT + F_ACT_B;                       constexpr size_t F_Y_B = alz((size_t)NPAIR * 4096 * 2);
constexpr size_t F_U = F_Y + F_Y_B;                           constexpr size_t F_U_B = alz((size_t)T * 2048 * 2);
constexpr size_t F_YG = F_U + F_U_B;                          constexpr size_t F_YG_B = alz((size_t)T * 2048 * 2);
constexpr size_t F_ELOC = F_YG + F_YG_B;                      constexpr size_t F_ELOC_B = alz((size_t)NB * S5G * 8 * S5P * 2 * 4);
constexpr size_t F_SS = F_ELOC + F_ELOC_B;                    constexpr size_t F_SS_B = 2 * alz((size_t)T * 128 * 4);
constexpr size_t F_RSTD = F_SS + F_SS_B;                      constexpr size_t F_RSTD_B = 2 * alz((size_t)T * 4);
constexpr size_t F_RS4 = F_RSTD + F_RSTD_B;                   constexpr size_t F_RS4_B = alz((size_t)T * 4);
constexpr size_t F_RS1 = F_RS4 + F_RS4_B;                     constexpr size_t F_RS1_B = alz((size_t)T * 4);
constexpr size_t F_END = F_RS1 + F_RS1_B;

constexpr int CW_TMO = 0, CW_BAR = 4096;
constexpr int LDS_BYTES = 147456;
constexpr int MISC_OFF = 131072 + 8192;
constexpr int TAB_OFF = 131072;

#define XB_TMO      128
#define XB_XCNT(j)  (256  + 64 * (j))
#define XB_XSUB(j)  (1280 + 64 * (j))
#define XB_XGEN(j)  (2304 + 64 * (j))
#define XB_TOP      3328
#define XB_TOPGEN   3392
#define XCD_BAR_WORDS 3456
#define XB_SPIN_CAP (1u << 18)
__device__ __forceinline__ unsigned xb_ld(unsigned* p)              { return __hip_atomic_load(p, __ATOMIC_RELAXED, __HIP_MEMORY_SCOPE_AGENT); }
__device__ __forceinline__ unsigned xb_add(unsigned* p, unsigned v) { return __hip_atomic_fetch_add(p, v, __ATOMIC_RELAXED, __HIP_MEMORY_SCOPE_AGENT); }
__device__ __forceinline__ unsigned xb_xcc_id() { return (unsigned)__builtin_amdgcn_s_getreg((3 << 11) | 20) & 0xFu; }
#define XB_SPIN(cond, bar) do { unsigned _sp = 0; while (cond) { __builtin_amdgcn_s_sleep(1); \
    if ((++_sp & 255u) == 0u) { if (xb_ld(&(bar)[XB_TMO])) break; if (_sp > XB_SPIN_CAP) { atomicAdd(&(bar)[XB_TMO], 1u); break; } } } } while (0)
struct XcdBarrier { unsigned* bar; unsigned x; volatile LAS unsigned* st; };
__device__ __forceinline__ XcdBarrier xcd_barrier_post(unsigned* bar, volatile LAS unsigned* st) {
    XcdBarrier b; b.bar = bar; b.x = xb_xcc_id(); b.st = st;
    if (threadIdx.x == 0) (void)xb_add(&bar[XB_XCNT(b.x)], 1u);
    return b;
}
__device__ __forceinline__ void xcd_barrier_complete(unsigned* bar, unsigned x, unsigned& nloc, unsigned& nx) {
    const unsigned G = gridDim.x * gridDim.y * gridDim.z;
    unsigned sum, cnt, mine, sp = 0u;
    for (;;) {
        sum = 0u; cnt = 0u; mine = 0u;
#pragma unroll
        for (unsigned j = 0; j < 16; ++j) { const unsigned c = xb_ld(&bar[XB_XCNT(j)]); sum += c; cnt += (c > 0u) ? 1u : 0u; mine = (j == x) ? c : mine; }
        if (sum == G) break;
        __builtin_amdgcn_s_sleep(1);
        if ((++sp & 255u) == 0u) { if (xb_ld(&bar[XB_TMO])) break; if (sp > XB_SPIN_CAP) { atomicAdd(&bar[XB_TMO], 1u); break; } }
    }
    nloc = mine > 0u ? mine : 1u; nx = cnt > 0u ? cnt : 1u;
}
__device__ __forceinline__ void xcd_barrier(const XcdBarrier& b) {
    asm volatile("s_waitcnt vmcnt(0)" ::: "memory");
    __syncthreads();
    if (threadIdx.x == 0) {
        unsigned* bar = b.bar;
        __builtin_amdgcn_s_waitcnt(0);
        unsigned nloc = b.st[0], nx = b.st[1];
        if (nloc == 0u) { xcd_barrier_complete(bar, b.x, nloc, nx); b.st[0] = nloc; b.st[1] = nx; }
        const unsigned old = xb_add(&bar[XB_XSUB(b.x)], 1u);
        const unsigned gen = old / nloc;
        if (old + 1u == (gen + 1u) * nloc) {
            __builtin_amdgcn_fence(__ATOMIC_RELEASE, "agent");
            asm volatile("s_waitcnt vmcnt(0)" ::: "memory");
            const unsigned og = xb_add(&bar[XB_TOP], 1u);
            const unsigned tg = og / nx;
            if (og + 1u == (tg + 1u) * nx) xb_add(&bar[XB_TOPGEN], 1u);
            else XB_SPIN(xb_ld(&bar[XB_TOPGEN]) == tg, bar);
            __builtin_amdgcn_fence(__ATOMIC_ACQUIRE, "agent");
            xb_add(&bar[XB_XGEN(b.x)], 1u);
            asm volatile("s_waitcnt vmcnt(0)" ::: "memory");
        } else {
            XB_SPIN(xb_ld(&bar[XB_XGEN(b.x)]) == gen, bar);
            __builtin_amdgcn_fence(__ATOMIC_ACQUIRE, "agent");
            asm volatile("s_waitcnt vmcnt(0)" ::: "memory");
        }
    }
    __syncthreads();
}

struct MapId   { __device__ __forceinline__ int operator()(int n) const { return n; } };
struct MapG1   { __device__ __forceinline__ int operator()(int n) const {
    if (n < 4096) return n;
    if (n < 4160) return FC_IK + (n - 4096);
    if (n < 4176) return FC_IW + (n - 4160);
    if (n < 5200) return FC_CQ + (n - 4176);
    if (n < 5712) return FC_CKV + (n - 5200);
    const int i = n - 5712; return FC_KR + ((i < 32) ? 2 * i : 2 * (i - 32) + 1); } };
struct MapUQ   { __device__ __forceinline__ int operator()(int n) const { const int h = n / 192, d = n % 192;
    if (d < 128) return h * 128 + d; const int i = d - 128; return 2048 + h * 64 + ((i < 32) ? 2 * i : 2 * (i - 32) + 1); } };
struct MapUKV  { __device__ __forceinline__ int operator()(int n) const { const int h = n >> 8, d = n & 255; return (d < 128) ? h * 128 + d : 2048 + h * 128 + (d - 128); } };
struct MapPair { int half; __device__ __forceinline__ int operator()(int n) const { const int hi = n >= half, j = hi ? n - half : n; return (j >> 7) * 256 + hi * 128 + (j & 127); } };
struct MapOff  { int off; __device__ __forceinline__ int operator()(int n) const { return n + off; } };

template <class Map>
__device__ __forceinline__ void tr_item(const float* __restrict__ W, int K, int N, bf16_t* WT, const float* __restrict__ kscale, int item, int lane, const Map& map) {
    const int nblk = (N + 31) >> 5, kb = item / nblk, nb = item - kb * nblk;
    const int c = lane & 7, nq = lane >> 3;
    const int k0 = kb * 64 + 8 * c, n = nb * 32 + 4 * nq;
    if (n < N) {
        f32x4 v[8];
#pragma unroll
        for (int i = 0; i < 8; ++i) v[i] = *(const f32x4*)(W + (size_t)(k0 + i) * N + n);
        if (kscale) {
#pragma unroll
            for (int i = 0; i < 8; ++i) v[i] *= kscale[k0 + i];
        }
#pragma unroll
        for (int j = 0; j < 4; ++j) {
            u32x4 o; o.x = cvt_pk_bf16(v[0][j], v[1][j]); o.y = cvt_pk_bf16(v[2][j], v[3][j]); o.z = cvt_pk_bf16(v[4][j], v[5][j]); o.w = cvt_pk_bf16(v[6][j], v[7][j]);
            *(u32x4*)(WT + (size_t)map(n + j) * K + k0) = o;
        }
    }
}
__device__ __forceinline__ void moe_conv4(const float* __restrict__ Wgu, const float* __restrict__ Wdn, bf16_t* Tgu, bf16_t* Tdn, const float* __restrict__ ks, int L, int id0, int step, int end, int lane) {
    const int c = lane & 7, nq = lane >> 3;
    f32x4 v[4][8], kv[4][2];
#pragma unroll
    for (int b = 0; b < 4; ++b) {
        const int id = id0 + b * step;
        if (id < end) {
            const int e = id / 3072, j = id - e * 3072, le = L * 32 + e; const bool gu = j < 2048; const int jj = gu ? j : j - 2048;
            const int N = gu ? 1024 : 4096, kb = gu ? (jj >> 5) : (jj >> 7), nb = gu ? (jj & 31) : (jj & 127), k0 = kb * 64 + 8 * c;
            const float* src = (gu ? Wgu + (size_t)le * 4096 * 1024 : Wdn + (size_t)le * 512 * 4096) + (size_t)k0 * N + nb * 32 + 4 * nq;
#pragma unroll
            for (int i = 0; i < 8; ++i) v[b][i] = __builtin_nontemporal_load((const f32x4*)(src + (size_t)i * N));
            if (gu) { kv[b][0] = *(const f32x4*)(ks + k0); kv[b][1] = *(const f32x4*)(ks + k0 + 4); }
        }
    }
#pragma unroll
    for (int b = 0; b < 4; ++b) {
        const int id = id0 + b * step;
        if (id < end) {
            const int e = id / 3072, j = id - e * 3072, le = L * 32 + e; const bool gu = j < 2048; const int jj = gu ? j : j - 2048;
            const int K = gu ? 4096 : 512, kb = gu ? (jj >> 5) : (jj >> 7), nb = gu ? (jj & 31) : (jj & 127), k0 = kb * 64 + 8 * c, n = nb * 32 + 4 * nq;
            if (gu) {
#pragma unroll
                for (int i = 0; i < 8; ++i) v[b][i] *= kv[b][i >> 2][i & 3];
            }
            bf16_t* dst = (gu ? Tgu + (size_t)le * 1024 * 4096 : Tdn + (size_t)le * 4096 * 512) + k0;
#pragma unroll
            for (int q = 0; q < 4; ++q) {
                u32x4 o; o.x = cvt_pk_bf16(v[b][0][q], v[b][1][q]); o.y = cvt_pk_bf16(v[b][2][q], v[b][3][q]); o.z = cvt_pk_bf16(v[b][4][q], v[b][5][q]); o.w = cvt_pk_bf16(v[b][6][q], v[b][7][q]);
                const int row = gu ? MapPair{512}(n + q) : n + q;
                __builtin_nontemporal_store(o, (u32x4*)(dst + (size_t)row * K));
            }
        }
    }
}
template <class Map>
__device__ __forceinline__ void tr_matrix(const float* W, int K, int N, bf16_t* WT, const float* kscale, int gw, int NGW, int lane, const Map& map) {
    const int nitems = (K >> 6) * ((N + 31) >> 5);
    for (int it = gw; it < nitems; it += NGW) tr_item(W, K, N, WT, kscale, it, lane, map);
}
__device__ __forceinline__ void cast_row_bf16(const float* xrow, bf16_t* orow, float* rs_out, int lane) {
    f32x4 v[16]; float s = 0.f;
#pragma unroll
    for (int j = 0; j < 16; ++j) { v[j] = ((const f32x4*)xrow)[lane + 64 * j]; s += (v[j].x * v[j].x + v[j].y * v[j].y) + (v[j].z * v[j].z + v[j].w * v[j].w); }
#pragma unroll
    for (int j = 0; j < 16; ++j) { u32x2 o; o.x = cvt_pk_bf16(v[j].x, v[j].y); o.y = cvt_pk_bf16(v[j].z, v[j].w); ((u32x2*)orow)[lane + 64 * j] = o; }
    const float rstd = rsqrtf(wave_sum(s) * (1.f / 4096.f) + 1e-6f);
    if (lane == 0) st_wt(rs_out, rstd);
}
__device__ __forceinline__ void norm_row_bf16(const float* xrow, const float* g, bf16_t* orow, int lane) {
    f32x4 v[16]; float s = 0.f;
#pragma unroll
    for (int j = 0; j < 16; ++j) { v[j] = ((const f32x4*)xrow)[lane + 64 * j]; s += (v[j].x * v[j].x + v[j].y * v[j].y) + (v[j].z * v[j].z + v[j].w * v[j].w); }
    const float rstd = rsqrtf(wave_sum(s) * (1.f / 4096.f) + 1e-6f);
#pragma unroll
    for (int j = 0; j < 16; ++j) { const f32x4 gg = ((const f32x4*)g)[lane + 64 * j];
        u32x2 o; o.x = cvt_pk_bf16(v[j].x * rstd * gg.x, v[j].y * rstd * gg.y); o.y = cvt_pk_bf16(v[j].z * rstd * gg.z, v[j].w * rstd * gg.w);
        ((u32x2*)orow)[lane + 64 * j] = o; }
}

namespace pg {
constexpr int BM = 256, BK = 64, HALF = 128, HTB = HALF * BK * 2, STAGE_BYTES = 8 * HTB, NXCD = 8, WGM = 8;
__host__ __device__ __forceinline__ int lds_byte(int r, int c) { const int st = (r >> 4) * 2 + (c >> 5), rr = r & 15, cc = c & 31, ob = rr * 64 + cc * 2; return st * 1024 + (ob ^ (((ob >> 9) & 1) << 5)); }
__host__ __device__ __forceinline__ void stage_rc(int b, int& R, int& C) { const int st = b / 1024, sb = b % 1024, swz = sb ^ (((sb >> 9) & 1) << 5); R = (st >> 1) * 16 + swz / 64; C = (st & 1) * 32 + (swz % 64) / 2; }
struct GUnit { const char* A; const char* B; int pm, pn, e, rows; };
#define EPI_ARGS const f32x4 (&acc)[2][2][4][2], const pg::GUnit& u, int wr, int wc, int fr, int fq

struct PlainSched {
    const char* A; const char* B; size_t tstepA, tstepB; int nM, nN, nwg, G, c, cnt;
    __device__ __forceinline__ void init(const void* A_, size_t ldaB, const void* B_, int K, int M, int N, int G_, int c_) {
        A = (const char*)A_; B = (const char*)B_; tstepA = 256 * ldaB; tstepB = (size_t)256 * K * 2; nM = M / BM; nN = N / BM; nwg = nM * nN; G = G_; c = c_; cnt = 1 << 30; }
    __device__ __forceinline__ void deal(int first, int step, int count) { c = first; G = step; cnt = count; }
    __device__ __forceinline__ bool next(int i, GUnit& u) const {
        const long L = (long)i * G + c; if (L >= nwg || i >= cnt) return false;
        int wgid = (int)L; { const int q = nwg / NXCD, r = nwg % NXCD, xcd = wgid % NXCD, off = wgid / NXCD; wgid = (xcd < r ? xcd * (q + 1) : r * (q + 1) + (xcd - r) * q) + off; }
        const int nig = WGM * nN, gid = wgid / nig, fm = gid * WGM, gsz = (nM - fm) < WGM ? (nM - fm) : WGM;
        u.pm = fm + ((wgid % nig) % gsz); u.pn = (wgid % nig) / gsz; u.e = 0; u.rows = 256;
        u.A = A + (size_t)u.pm * tstepA; u.B = B + (size_t)u.pn * tstepB; return true;
    }
};
struct RouterSched {
    const char* A; const char* B; int G, c;
    __device__ __forceinline__ bool next(int i, GUnit& u) const {
        const int L = i * G + c; if (L >= 256) return false;
        u.pm = L >> 3; u.pn = L & 7; u.e = 0; u.rows = 256;
        u.A = A + (size_t)u.pm * 256 * 8192 + (size_t)u.pn * 1024; u.B = B + (size_t)u.pn * 1024; return true;
    }
};
struct MoeSched {
    const char* A; const char* B; const unsigned* cnt; size_t ldaB, tstepB, bexp; int NT, ntsh, G, c; int gather; int first, step, lim; LAS const unsigned char* tab;
    __device__ __forceinline__ void load_counts(LAS unsigned char* lds) {
        tab = lds + TAB_OFF;
        if (threadIdx.x < 64) {
            const int l = threadIdx.x & 63;
            const int n = (int)__hip_atomic_load(cnt + (l & 31), RLX_AGENT);
            const int mf = n >> 8, rem = n & 255;
            int u1 = (mf + (rem > 128 ? 1 : 0)) * NT, u2 = (rem > 0 && rem <= 128) ? NT : 0, pd = ((n + 255) >> 8) * 256;
            if (l >= 32) { u1 = 0; u2 = 0; pd = 0; }
            int s1 = u1, s2 = u2, sp = pd;
#pragma unroll
            for (int d = 1; d < 32; d <<= 1) { const int t1 = __shfl_up(s1, d), t2 = __shfl_up(s2, d), tp = __shfl_up(sp, d); if (l >= d) { s1 += t1; s2 += t2; sp += tp; } }
            const int tot1 = __shfl(s1, 31), tot2 = __shfl(s2, 31);
            if (l < 32) *(LAS i32x4*)(lds + TAB_OFF + l * 16) = (i32x4){s1 - u1, tot1 + s2 - u2, sp - pd, n};
            if (l == 32) *(LAS i32x4*)(lds + TAB_OFF + 32 * 16) = (i32x4){tot1, tot2, 0, 0};
        }
        __syncthreads();
    }
    __device__ __forceinline__ int total() const { const i32x4 g = *(LAS const i32x4*)(tab + 32 * 16); return __builtin_amdgcn_readfirstlane(g.x + g.y); }
    __device__ __forceinline__ int u1() const { const i32x4 g = *(LAS const i32x4*)(tab + 32 * 16); return __builtin_amdgcn_readfirstlane(g.x); }
    __device__ __forceinline__ bool next(int i, GUnit& u) const {
        if (i >= lim) return false;
        const int L = first + i * step;
        const i32x4 t = *(LAS const i32x4*)(tab + (threadIdx.x & 31) * 16);
        const int n = t.w, mf = n >> 8, rem = n & 255;
        const int u1 = (mf + (rem > 128 ? 1 : 0)) * NT, u2 = (rem > 0 && rem <= 128) ? NT : 0;
        const unsigned long long m1 = __ballot(L >= t.x && L < t.x + u1), m2 = __ballot(L >= t.y && L < t.y + u2);
        if ((m1 | m2) == 0ull) return false;
        const bool p1 = m1 != 0ull;
        const int e = __builtin_ctzll(p1 ? m1 : m2);
        const int ne = __builtin_amdgcn_readlane(n, e), rowbase = __builtin_amdgcn_readlane(t.z, e);
        const int loc = L - (p1 ? __builtin_amdgcn_readlane(t.x, e) : __builtin_amdgcn_readlane(t.y, e));
        const int mfe = ne >> 8, reme = ne & 255;
        const int m = p1 ? (loc >> ntsh) : mfe, nt = p1 ? (loc & (NT - 1)) : loc;
        u.pm = (rowbase >> 8) + m; u.pn = nt; u.e = e; u.rows = (m < mfe) ? 256 : reme;
        u.A = gather ? A : A + (size_t)(rowbase + m * 256) * ldaB; u.B = B + (size_t)e * bexp + (size_t)nt * tstepB; return true;
    }
};

template <class Epi, class Sched, bool GATHER = false, bool SKIPDEAD = false>
__device__ __forceinline__ void gemm_phase(LAS unsigned char* lds, const int K, const size_t ldaB, const Sched& S, const Epi& E, const size_t ldbB_ = 0, const int* rowtab = nullptr) {
    int tid = threadIdx.x; asm volatile("" : "+v"(tid));
    const int wid = __builtin_amdgcn_readfirstlane(tid >> 6), lane = tid & 63, wr = wid >> 2, wc = wid & 3, fr = lane & 15, fq = lane >> 4;
    const int nt = K / BK; const size_t ldbB = ldbB_ ? ldbB_ : (size_t)K * 2;
    unsigned voffA[2], voffB[2]; int gR[2], gC[2];
#pragma unroll
    for (int i = 0; i < 2; ++i) { int R, C; stage_rc(tid * 16 + i * 8192, R, C); gR[i] = R; gC[i] = C * 2; voffA[i] = (unsigned)(R * ldaB + C * 2); voffB[i] = (unsigned)(R * ldbB + C * 2); }
    unsigned gcur[2][2], gnxt[2][2];
#define PG_GOFF(dst, uu) do { _Pragma("unroll") for (int h_ = 0; h_ < 2; ++h_) _Pragma("unroll") for (int i_ = 0; i_ < 2; ++i_) \
        dst[h_][i_] = (unsigned)(rowtab[(uu).pm * 256 + h_ * 128 + gR[i_]] >> 1) * (unsigned)ldaB + (unsigned)gC[i_]; } while (0)
    const size_t kstep = (size_t)(BK * 2);
    const size_t hstepA = (size_t)HALF * ldaB, hstepB = (size_t)HALF * ldbB;
    const unsigned ldsw = (unsigned)wid * 1024u;
    const int aoff = lds_byte(wr * 64 + fr, fq * 8), boff = lds_byte(wc * 32 + fr, fq * 8);
#define PG_SA(b, h) (((b) * 2 + (h)) * HTB)
#define PG_SB(b, h) ((4 + (b) * 2 + (h)) * HTB)
#define PG_STAGE(bufoff, gbase, voff) do { _Pragma("unroll") for (int _i = 0; _i < 2; ++_i) \
        __builtin_amdgcn_global_load_lds((const unsigned*)((const char*)(gbase) + (voff)[_i]), (LAS unsigned*)(lds + (bufoff) + ldsw + _i * 8192), 16, 0, 0); } while (0)
#define PG_STAGE_A(bufoff, gbase, h, isnext) do { if constexpr (GATHER) { _Pragma("unroll") for (int _i = 0; _i < 2; ++_i) \
        __builtin_amdgcn_global_load_lds((const unsigned*)((const char*)(gbase) + ((isnext) ? gnxt[h][_i] : gcur[h][_i])), (LAS unsigned*)(lds + (bufoff) + ldsw + _i * 8192), 16, 0, 0); } \
        else { PG_STAGE(bufoff, (gbase) + (h) * hstepA, voffA); } } while (0)
#define PG_LDA(dst, b, h) do { _Pragma("unroll") for (int m = 0; m < 4; ++m) _Pragma("unroll") for (int k = 0; k < 2; ++k) dst[m][k] = *(const LAS bf16x8*)(lds + PG_SA(b, h) + aoff + m * 2048 + k * 1024); } while (0)
#define PG_LDB(dst, b, h) do { _Pragma("unroll") for (int n = 0; n < 2; ++n) _Pragma("unroll") for (int k = 0; k < 2; ++k) dst[n][k] = *(const LAS bf16x8*)(lds + PG_SB(b, h) + boff + n * 2048 + k * 1024); } while (0)
#define PG_MMA(ai, bj, At, Bt) do { __builtin_amdgcn_s_setprio(1); _Pragma("unroll") for (int m = 0; m < 4; ++m) _Pragma("unroll") for (int n = 0; n < 2; ++n) _Pragma("unroll") for (int k = 0; k < 2; ++k) \
        acc[ai][bj][m][n] = __builtin_amdgcn_mfma_f32_16x16x32_bf16(Bt[n][k], At[m][k], acc[ai][bj][m][n], 0, 0, 0); __builtin_amdgcn_s_setprio(0); } while (0)
#define PG_WAIT_V(n) asm volatile("s_waitcnt vmcnt(" #n ")" ::: "memory")
#define PG_WAIT_L(n) asm volatile("s_waitcnt lgkmcnt(" #n ")" ::: "memory")
#define PG_BAR __builtin_amdgcn_s_barrier()
#define PG_SCHED __builtin_amdgcn_sched_barrier(0)
    GUnit cur, nxt; int ui = 0;
    if (!S.next(0, cur)) return;
    f32x4 acc[2][2][4][2];
#pragma unroll
    for (int a = 0; a < 2; ++a)
#pragma unroll
        for (int b = 0; b < 2; ++b)
#pragma unroll
            for (int m = 0; m < 4; ++m)
#pragma unroll
                for (int n = 0; n < 2; ++n) acc[a][b][m][n] = (f32x4){0.f, 0.f, 0.f, 0.f};
    bf16x8 At[4][2], B0[2][2], B1[2][2];
    const char* cA = cur.A; const char* cB = cur.B;
    if constexpr (GATHER) { PG_GOFF(gcur, cur); }
    PG_STAGE(PG_SB(0, 0), cB, voffB); PG_STAGE(PG_SB(0, 1), cB + hstepB, voffB); PG_STAGE_A(PG_SA(0, 0), cA, 0, false); PG_STAGE_A(PG_SA(0, 1), cA, 1, false);
    if (wr == 1) PG_BAR;
    PG_WAIT_V(2); PG_BAR;
    PG_STAGE(PG_SB(1, 0), cB + kstep, voffB); PG_STAGE_A(PG_SA(1, 0), cA + kstep, 0, false); PG_STAGE(PG_SB(1, 1), cB + hstepB + kstep, voffB);
    PG_WAIT_V(6); PG_BAR;
    for (;;) {
        const bool has_next = S.next(ui + 1, nxt);
        const char* nA = has_next ? nxt.A : cA; const char* nB = has_next ? nxt.B : cB;
        if constexpr (GATHER) { if (has_next) { PG_GOFF(gnxt, nxt); } }
        const bool live1 = !SKIPDEAD || cur.rows > 128;
        for (int t = 0; t < nt; t += 2) {
            const bool last = (t == nt - 2); const bool nx_ = last && has_next;
            const char* a1 = cA + (size_t)(t + 1) * kstep;
            const char* a2 = last ? nA : cA + (size_t)(t + 2) * kstep; const char* b2 = last ? nB : cB + (size_t)(t + 2) * kstep;
            const char* a3 = a2 + kstep; const char* b3 = b2 + kstep;
            PG_LDB(B0, 0, 0); PG_LDB(B1, 0, 1); PG_SCHED; PG_LDA(At, 0, 0); PG_STAGE_A(PG_SA(1, 1), a1, 1, false);
            PG_WAIT_V(8); PG_WAIT_L(0); PG_BAR; PG_MMA(0, 0, At, B0); PG_MMA(0, 1, At, B1); PG_BAR; PG_SCHED;
            PG_LDA(At, 0, 1); PG_STAGE(PG_SB(0, 0), b2, voffB); PG_STAGE(PG_SB(0, 1), b2 + hstepB, voffB); PG_STAGE_A(PG_SA(0, 0), a2, 0, nx_);
            PG_WAIT_V(8); PG_WAIT_L(0); PG_BAR; if (live1) { PG_MMA(1, 0, At, B0); PG_MMA(1, 1, At, B1); } PG_BAR; PG_SCHED;
            PG_LDB(B0, 1, 0); PG_LDB(B1, 1, 1); PG_SCHED; PG_LDA(At, 1, 0); PG_STAGE_A(PG_SA(0, 1), a2, 1, nx_);
            PG_WAIT_V(8); PG_WAIT_L(0); PG_BAR; PG_MMA(0, 0, At, B0); PG_MMA(0, 1, At, B1); PG_BAR; PG_SCHED;
            PG_LDA(At, 1, 1); PG_STAGE(PG_SB(1, 0), b3, voffB); PG_STAGE(PG_SB(1, 1), b3 + hstepB, voffB); PG_STAGE_A(PG_SA(1, 0), a3, 0, nx_);
            PG_WAIT_V(8); PG_WAIT_L(0); PG_BAR; if (live1) { PG_MMA(1, 0, At, B0); PG_MMA(1, 1, At, B1); } PG_BAR; PG_SCHED;
        }
        if (wr == 0) PG_BAR;
        E(acc, cur, wr, wc, fr, fq);
        if (!has_next) break;
#pragma unroll
        for (int a = 0; a < 2; ++a)
#pragma unroll
            for (int b = 0; b < 2; ++b)
#pragma unroll
                for (int m = 0; m < 4; ++m)
#pragma unroll
                    for (int n = 0; n < 2; ++n) acc[a][b][m][n] = (f32x4){0.f, 0.f, 0.f, 0.f};
        cur = nxt; cA = nA; cB = nB; ++ui;
        if constexpr (GATHER) { _Pragma("unroll") for (int h_ = 0; h_ < 2; ++h_) _Pragma("unroll") for (int i_ = 0; i_ < 2; ++i_) gcur[h_][i_] = gnxt[h_][i_]; }
        if (wr == 1) PG_BAR;
    }
    PG_WAIT_V(0);
    PG_BAR;
    asm volatile("s_waitcnt vmcnt(0) lgkmcnt(0)" ::: "memory"); __syncthreads();
#undef PG_SA
#undef PG_STAGE_A
#undef PG_GOFF
#undef PG_SB
#undef PG_STAGE
#undef PG_LDA
#undef PG_LDB
#undef PG_MMA
#undef PG_WAIT_V
#undef PG_WAIT_L
#undef PG_BAR
#undef PG_SCHED
}
}

__device__ __forceinline__ void rope4(f32x4& v, float pos, int i0) {
#pragma unroll
    for (int h = 0; h < 2; ++h) {
        const float inv = exp2f(-(float)(i0 + h) * 0.41524101186092029f);
        const float ang = pos * inv; const float c = __cosf(ang), s = __sinf(ang);
        const float t1 = v[2 * h], t2 = v[2 * h + 1];
        v[2 * h] = t1 * c - t2 * s; v[2 * h + 1] = t2 * c + t1 * s;
    }
}
struct EpiG1 {
    bf16_t* P; float* statq; float* statkv; const int* pos; const float* rstd;
    __device__ __forceinline__ void operator()(EPI_ARGS) const {
        const int row0 = u.pm * 256 + wr * 64 + fr, colt = u.pn * 256 + wc * 32 + 4 * fq;
        const bool rope_tile = (u.pn == 22) && (wc >= 2);
        const bool sq = (u.pn >= 16 && u.pn < 20), skv = (u.pn == 20 || u.pn == 21);
        float rsv[2][4];
#pragma unroll
        for (int ai = 0; ai < 2; ++ai)
#pragma unroll
            for (int m = 0; m < 4; ++m) rsv[ai][m] = rstd[row0 + ai * 128 + m * 16];
#pragma unroll
        for (int ai = 0; ai < 2; ++ai)
#pragma unroll
            for (int m = 0; m < 4; ++m) {
                const int row = row0 + ai * 128 + m * 16; bf16_t* rowp = P + (size_t)row * PWF + colt; float ss = 0.f;
                const float ps = rope_tile ? (float)pos[row] : 0.f;
#pragma unroll
                for (int bj = 0; bj < 2; ++bj)
#pragma unroll
                    for (int n = 0; n < 2; ++n) { f32x4 v = acc[ai][bj][m][n] * rsv[ai][m];
                        if (rope_tile && bj == 0) { const int i0 = ((wc - 2) * 32 + n * 16 + 4 * fq) >> 1; rope4(v, ps, i0); }
                        ss += (v[0] * v[0] + v[1] * v[1]) + (v[2] * v[2] + v[3] * v[3]);
                        u32x2 o; o.x = cvt_pk_bf16(v[0], v[1]); o.y = cvt_pk_bf16(v[2], v[3]); *(u32x2*)(rowp + bj * 128 + n * 16) = o; }
                if (sq || skv) { ss += __shfl_xor(ss, 16); ss += __shfl_xor(ss, 32);
                    if (fq == 0) { if (sq) st_wt(statq + (size_t)row * 16 + (u.pn - 16) * 4 + wc, ss); else st_wt(statkv + (size_t)row * 8 + (u.pn - 20) * 4 + wc, ss); } }
            }
    }
};
template <int NPART, int KDIM, int ROPE_TILE0  > struct EpiNormed {
    bf16_t* O; int ldo; const float* stat; const int* pos;
    __device__ __forceinline__ void operator()(EPI_ARGS) const {
        const int row0 = u.pm * 256 + wr * 64 + fr, colt = u.pn * 256 + wc * 32 + 4 * fq;
        const bool rope_tile = u.pn >= ROPE_TILE0;
#pragma unroll
        for (int ai = 0; ai < 2; ++ai)
#pragma unroll
            for (int m = 0; m < 4; ++m) {
                const int row = row0 + ai * 128 + m * 16; float s = 0.f;
#pragma unroll
                for (int i = 0; i < NPART / 4; ++i) { const f32x4 q = *(const f32x4*)(stat + (size_t)row * NPART + 4 * i); s += (q[0] + q[1]) + (q[2] + q[3]); }
                const float rstd = rsqrtf(s * (1.f / (float)KDIM) + 1e-6f);
                const float ps = rope_tile ? (float)pos[row] : 0.f;
                bf16_t* rowp = O + (size_t)row * ldo + colt;
#pragma unroll
                for (int bj = 0; bj < 2; ++bj)
#pragma unroll
                    for (int n = 0; n < 2; ++n) { f32x4 v = acc[ai][bj][m][n] * rstd;
                        if (rope_tile) { const int i0 = ((bj * 128 + wc * 32 + n * 16 + 4 * fq) & 63) >> 1; rope4(v, ps, i0); }
                        u32x2 o; o.x = cvt_pk_bf16(v[0], v[1]); o.y = cvt_pk_bf16(v[2], v[3]); *(u32x2*)(rowp + bj * 128 + n * 16) = o; }
            }
    }
};
struct EpiRes {
    const bf16_t* Xi; bf16_t* H; float* SS;
    __device__ __forceinline__ void operator()(EPI_ARGS) const {
        const int row0 = u.pm * 256 + wr * 64 + fr, colt = u.pn * 256 + wc * 32 + 4 * fq;
#pragma unroll
        for (int ai = 0; ai < 2; ++ai)
#pragma unroll
            for (int m = 0; m < 4; ++m) { const int row = row0 + ai * 128 + m * 16; const size_t off = (size_t)row * 4096 + colt; float ss = 0.f;
#pragma unroll
                for (int bj = 0; bj < 2; ++bj)
#pragma unroll
                    for (int n = 0; n < 2; ++n) { const u32x2 xr = *(const u32x2*)(Xi + off + bj * 128 + n * 16); const f32x4 o = (f32x4){bf_lo(xr.x), bf_hi(xr.x), bf_lo(xr.y), bf_hi(xr.y)} + acc[ai][bj][m][n];
                        ss += (o[0] * o[0] + o[1] * o[1]) + (o[2] * o[2] + o[3] * o[3]);
                        u32x2 w; w.x = cvt_pk_bf16(o[0], o[1]); w.y = cvt_pk_bf16(o[2], o[3]); *(u32x2*)(H + off + bj * 128 + n * 16) = w; }
                ss += __shfl_xor(ss, 16); ss += __shfl_xor(ss, 32);
                if (fq == 0) st_wt(SS + (size_t)row * 128 + u.pn * 4 + wc, ss); }
    }
};
struct EpiBf16 {
    bf16_t* O; int ldo;
    __device__ __forceinline__ void operator()(EPI_ARGS) const {
        const int row0 = u.pm * 256 + wr * 64 + fr, colt = u.pn * 256 + wc * 32 + 4 * fq;
#pragma unroll
        for (int ai = 0; ai < 2; ++ai)
#pragma unroll
            for (int m = 0; m < 4; ++m) { bf16_t* rowp = O + (size_t)(row0 + ai * 128 + m * 16) * ldo + colt;
#pragma unroll
                for (int bj = 0; bj < 2; ++bj)
#pragma unroll
                    for (int n = 0; n < 2; ++n) { const f32x4 v = acc[ai][bj][m][n]; u32x2 o; o.x = cvt_pk_bf16(v[0], v[1]); o.y = cvt_pk_bf16(v[2], v[3]); *(u32x2*)(rowp + bj * 128 + n * 16) = o; } }
    }
};
struct EpiBf16R {
    bf16_t* O; int ldo; const float* rstd;
    __device__ __forceinline__ void operator()(EPI_ARGS) const {
        const int row0 = u.pm * 256 + wr * 64 + fr, colt = u.pn * 256 + wc * 32 + 4 * fq;
        float rs[2][4];
#pragma unroll
        for (int ai = 0; ai < 2; ++ai)
#pragma unroll
            for (int m = 0; m < 4; ++m) rs[ai][m] = rstd[row0 + ai * 128 + m * 16];
#pragma unroll
        for (int ai = 0; ai < 2; ++ai)
#pragma unroll
            for (int m = 0; m < 4; ++m) { bf16_t* rowp = O + (size_t)(row0 + ai * 128 + m * 16) * ldo + colt;
#pragma unroll
                for (int bj = 0; bj < 2; ++bj)
#pragma unroll
                    for (int n = 0; n < 2; ++n) { const f32x4 v = acc[ai][bj][m][n] * rs[ai][m]; u32x2 o; o.x = cvt_pk_bf16(v[0], v[1]); o.y = cvt_pk_bf16(v[2], v[3]); *(u32x2*)(rowp + bj * 128 + n * 16) = o; } }
    }
};
struct EpiLogits {
    float* L;
    __device__ __forceinline__ void operator()(EPI_ARGS) const {
        if (wc >= 2) return;
        const int row0 = u.pm * 256 + wr * 64 + fr;
#pragma unroll
        for (int ai = 0; ai < 2; ++ai)
#pragma unroll
            for (int m = 0; m < 4; ++m)
#pragma unroll
                for (int n = 0; n < 2; ++n) *(f32x4*)(L + ((size_t)u.pn * T + (row0 + ai * 128 + m * 16)) * 64 + wc * 32 + n * 16 + 4 * fq) = acc[ai][0][m][n];
    }
};
struct EpiSilu {
    bf16_t* Act; const int* prow; const float* rstd; unsigned* tc;
    __device__ __forceinline__ void operator()(EPI_ARGS) const {
        const int row0 = u.pm * 256 + wr * 64 + fr, colt = u.pn * 128 + wc * 32 + 4 * fq;
#pragma unroll
        for (int ai = 0; ai < 2; ++ai)
#pragma unroll
            for (int m = 0; m < 4; ++m) { const int gr = row0 + ai * 128 + m * 16; const float rs = rstd[prow[gr] >> 1]; bf16_t* rowp = Act + (size_t)gr * 512 + colt;
#pragma unroll
                for (int n = 0; n < 2; ++n) { const f32x4 g = acc[ai][0][m][n] * rs, up = acc[ai][1][m][n] * rs; f32x4 h;
#pragma unroll
                    for (int j = 0; j < 4; ++j) h[j] = g[j] / (1.f + __expf(-g[j])) * up[j];
                    st_wt8(rowp + n * 16, cvt_pk_bf16(h[0], h[1]), cvt_pk_bf16(h[2], h[3])); } }
        asm volatile("s_waitcnt vmcnt(0)" ::: "memory");
        if (fr == 0 && fq == 0) (void)__hip_atomic_fetch_add(tc + u.pm * 32, 1u, __ATOMIC_RELAXED, __HIP_MEMORY_SCOPE_AGENT);
    }
};
struct EpiDown {
    bf16_t* Y; const int* prow; const float* wrow;
    __device__ __forceinline__ void operator()(EPI_ARGS) const {
        const int colt = u.pn * 256 + wc * 32 + 4 * fq;
#pragma unroll
        for (int ai = 0; ai < 2; ++ai)
#pragma unroll
            for (int m = 0; m < 4; ++m) { const int lr = ai * 128 + wr * 64 + m * 16 + fr;
                if (lr < u.rows) { const int gr = u.pm * 256 + lr; const int pair = prow[gr]; const float w = wrow[gr]; bf16_t* rowp = Y + (size_t)pair * 4096 + colt;
#pragma unroll
                    for (int bj = 0; bj < 2; ++bj)
#pragma unroll
                        for (int n = 0; n < 2; ++n) { const f32x4 v = acc[ai][bj][m][n] * w; u32x2 o; o.x = cvt_pk_bf16(v[0], v[1]); o.y = cvt_pk_bf16(v[2], v[3]); *(u32x2*)(rowp + bj * 128 + n * 16) = o; } } }
    }
};
struct EpiGlu {
    const bf16_t* Xi; bf16_t* H; float* SS;
    __device__ __forceinline__ void operator()(EPI_ARGS) const {
        const int row0 = u.pm * 256 + wr * 64 + fr, colt = u.pn * 128 + wc * 32 + 4 * fq;
#pragma unroll
        for (int ai = 0; ai < 2; ++ai)
#pragma unroll
            for (int m = 0; m < 4; ++m) { const int row = row0 + ai * 128 + m * 16; const size_t off = (size_t)row * 4096 + colt; float ss = 0.f;
#pragma unroll
                for (int n = 0; n < 2; ++n) { const f32x4 v = acc[ai][0][m][n], g = acc[ai][1][m][n]; const u32x2 xr = *(const u32x2*)(Xi + off + n * 16); f32x4 r = {bf_lo(xr.x), bf_hi(xr.x), bf_lo(xr.y), bf_hi(xr.y)};
#pragma unroll
                    for (int j = 0; j < 4; ++j) r[j] += v[j] / (1.f + __expf(-g[j]));
                    ss += (r[0] * r[0] + r[1] * r[1]) + (r[2] * r[2] + r[3] * r[3]);
                    u32x2 w; w.x = cvt_pk_bf16(r[0], r[1]); w.y = cvt_pk_bf16(r[2], r[3]); *(u32x2*)(H + off + n * 16) = w; }
                ss += __shfl_xor(ss, 16); ss += __shfl_xor(ss, 32);
                if (fq == 0) st_wt(SS + (size_t)row * 128 + u.pn * 4 + wc, ss); }
    }
};

__device__ __forceinline__ void indexer_unit(const bf16_t* __restrict__ P, unsigned* mask, int b, int qp, int lane) {
    const int n = lane & 31, hi = lane >> 5, q0 = 2 * qp;
    const size_t tok0 = (size_t)b * SEQ;
    const int aq = q0 + ((n >> 2) & 1), ah = (n & 3) + 4 * (n >> 3);
    const bf16_t* ap = P + (tok0 + aq) * PWF + FC_IQ + ah * 64 + 8 * hi;
    bf16x8 af[4];
#pragma unroll
    for (int ks = 0; ks < 4; ++ks) af[ks] = *(const bf16x8*)(ap + 16 * ks);
    float w[16];
    { const u32x4 w0 = *(const u32x4*)(P + (tok0 + q0 + hi) * PWF + FC_IW), w1 = *(const u32x4*)(P + (tok0 + q0 + hi) * PWF + FC_IW + 8);
      const float sc_ = 0.03125f;
#pragma unroll
      for (int i = 0; i < 4; ++i) { w[2 * i] = bf_lo(w0[i]) * sc_; w[2 * i + 1] = bf_hi(w0[i]) * sc_; w[8 + 2 * i] = bf_lo(w1[i]) * sc_; w[8 + 2 * i + 1] = bf_hi(w1[i]) * sc_; } }
    const int njt = (q0 + 1) / 32 + 1;
    const int myq = q0 + hi;
    unsigned sc[64];
    const bf16_t* kp = P + (tok0 + n) * PWF + FC_IK + 8 * hi;
    bf16x8 kb[3][4];
#define IDX_LD(jt_) do { const bf16_t* kq_ = kp + (size_t)(jt_) * 32 * PWF; _Pragma("unroll") for (int ks = 0; ks < 4; ++ks) kb[(jt_) % 3][ks] = *(const bf16x8*)(kq_ + 16 * ks); } while (0)
    IDX_LD(0);
    if (1 < njt) IDX_LD(1);
#pragma unroll
    for (int jt = 0; jt < 64; ++jt) {
        unsigned kv = 0u;
        if (jt < njt) {
            if (jt + 2 < 64 && jt + 2 < njt) IDX_LD(jt + 2);
            f32x16 acc = {};
#pragma unroll
            for (int ks = 0; ks < 4; ++ks) acc = __builtin_amdgcn_mfma_f32_32x32x16_bf16(af[ks], kb[jt % 3][ks], acc, 0, 0, 0);
            float s = 0.f;
#pragma unroll
            for (int r = 0; r < 16; ++r) s = fmaf(w[r], fmaxf(acc[r], 0.f), s);
            const unsigned uu = __float_as_uint(s); const unsigned ok = (uu & 0x80000000u) ? ~uu : (uu | 0x80000000u);
            kv = (jt * 32 + n <= myq) ? ok : 0u;
        }
        sc[jt] = kv;
    }
#undef IDX_LD
    const int L = myq + 1;
    unsigned prefix = 0u; bool fin = (L <= NSEL);
    for (int bit = 31; bit >= 0; --bit) {
        const unsigned cand = prefix | (1u << bit);
        int c = 0;
#pragma unroll
        for (int jt = 0; jt < 64; ++jt) c += (sc[jt] >= cand) ? 1 : 0;
#pragma unroll
        for (int o = 1; o < 32; o <<= 1) c += __shfl_xor(c, o);
        if (!fin) { if (c >= NSEL) prefix = cand; if (c == NSEL) fin = true; }
        if (__all(fin)) break;
    }
    if (L <= NSEL) prefix = 1u;
    unsigned mylo = 0u, myhi = 0u;
#pragma unroll
    for (int jt = 0; jt < 64; ++jt) {
        const unsigned long long m = __ballot(sc[jt] >= prefix);
        if (lane == jt) { mylo = (unsigned)m; myhi = (unsigned)(m >> 32); }
    }
    mask[(tok0 + q0) * 64 + lane] = mylo;
    mask[(tok0 + q0 + 1) * 64 + lane] = myhi;
}

namespace att {
constexpr int SHM_V = 16384;
__device__ __forceinline__ int v_st(int k, int c) { const int kk = (k & ~0xC) | ((k & 4) << 1) | ((k & 8) >> 1); return ((kk >> 3) * 4 + (c >> 5)) * 512 + ((kk & 7) * 32 + (c & 31)) * 2; }
__device__ __forceinline__ int v_rd_base(int lane) { return ((lane & 3) << 3) | (((lane >> 2) & 3) << 6) | (((lane >> 4) & 1) << 5) | (((lane >> 5) & 1) << 8); }
constexpr int v_rd_off(int d0, int ks, int half) { return d0 * 512 + ks * 4096 + half * 2048; }
__device__ __forceinline__ int crow(int r, int hi) { return (r & 3) + 8 * (r >> 2) + 4 * hi; }
#define ATT_SBAR() __builtin_amdgcn_sched_barrier(0)

template <int VB>
__device__ __forceinline__ void pv_tile(f32x16* o, int vb0, bf16x8 pa0, bf16x8 pa1, bf16x8 pa2, bf16x8 pa3) {
#define TRRD(dst, off) asm volatile("ds_read_b64_tr_b16 %0, %1 offset:%2" : "=&v"(dst) : "v"(vb0), "i"(off) : "memory")
#define PV_D0(d0) do { s16x4 l0, l1, l2, l3, h0, h1, h2, h3; constexpr int b_ = VB * SHM_V + v_rd_off(d0, 0, 0); \
        TRRD(l0, b_); TRRD(h0, b_ + 2048); TRRD(l1, b_ + 4096); TRRD(h1, b_ + 6144); TRRD(l2, b_ + 8192); TRRD(h2, b_ + 10240); TRRD(l3, b_ + 12288); TRRD(h3, b_ + 14336); \
        asm volatile("s_waitcnt lgkmcnt(0)" ::: "memory"); ATT_SBAR(); \
        o[d0] = __builtin_amdgcn_mfma_f32_32x32x16_bf16(pa0, (bf16x8){l0[0], l0[1], l0[2], l0[3], h0[0], h0[1], h0[2], h0[3]}, o[d0], 0, 0, 0); \
        o[d0] = __builtin_amdgcn_mfma_f32_32x32x16_bf16(pa1, (bf16x8){l1[0], l1[1], l1[2], l1[3], h1[0], h1[1], h1[2], h1[3]}, o[d0], 0, 0, 0); \
        o[d0] = __builtin_amdgcn_mfma_f32_32x32x16_bf16(pa2, (bf16x8){l2[0], l2[1], l2[2], l2[3], h2[0], h2[1], h2[2], h2[3]}, o[d0], 0, 0, 0); \
        o[d0] = __builtin_amdgcn_mfma_f32_32x32x16_bf16(pa3, (bf16x8){l3[0], l3[1], l3[2], l3[3], h3[0], h3[1], h3[2], h3[3]}, o[d0], 0, 0, 0); } while (0)
    PV_D0(0); PV_D0(1); PV_D0(2); PV_D0(3);
#undef PV_D0
#undef TRRD
}

template <int VB, int SUBT>
__device__ __forceinline__ void pv_half(f32x16* o, int vb0, bf16x8 pa0, bf16x8 pa1) {
#define TRRD(dst, off) asm volatile("ds_read_b64_tr_b16 %0, %1 offset:%2" : "=&v"(dst) : "v"(vb0), "i"(off) : "memory")
#define PV_H0(d0) do { s16x4 l0, l1, h0, h1; constexpr int b_ = VB * SHM_V + v_rd_off(d0, 2 * SUBT, 0); \
        TRRD(l0, b_); TRRD(h0, b_ + 2048); TRRD(l1, b_ + 4096); TRRD(h1, b_ + 6144); \
        asm volatile("s_waitcnt lgkmcnt(0)" ::: "memory"); ATT_SBAR(); \
        o[d0] = __builtin_amdgcn_mfma_f32_32x32x16_bf16(pa0, (bf16x8){l0[0], l0[1], l0[2], l0[3], h0[0], h0[1], h0[2], h0[3]}, o[d0], 0, 0, 0); \
        o[d0] = __builtin_amdgcn_mfma_f32_32x32x16_bf16(pa1, (bf16x8){l1[0], l1[1], l1[2], l1[3], h1[0], h1[1], h1[2], h1[3]}, o[d0], 0, 0, 0); } while (0)
    PV_H0(0); PV_H0(1); PV_H0(2); PV_H0(3);
#undef PV_H0
#undef TRRD
}

struct AttPtrs {
    const bf16_t* Qn; int ldq; const bf16_t* Qr; int ldqr;
    const bf16_t* Kn; int ldk; const bf16_t* Kr; int ldkr;
    const bf16_t* V; int ldv; bf16_t* O; int ldo; const unsigned* mask; float c2;
};

template <int DQK, bool BITMASK>
__device__ __forceinline__ void attn_qblock(LAS char* lds, const AttPtrs& A, const int qb) {
    constexpr int KROW = DQK * 2 + 16, KBUF = 64 * KROW, NKC = DQK / 8, KPT = NKC / 8;
    int tid = threadIdx.x; asm volatile("" : "+v"(tid));
    const int wid = __builtin_amdgcn_readfirstlane(tid >> 6), lane = tid & 63, r32 = lane & 31, hi = lane >> 5;
    LAS char* V_lds = lds; LAS char* K_lds = lds + 2 * SHM_V;
    LAS float* wsf = (LAS float*)(lds + 2 * SHM_V + 2 * KBUF) + wid * 64; LAS float* li_l = wsf; LAS float* al_l = wsf + 32;
    const int qlo = qb * 256 + wid * 32, qrow = qlo + r32;
    const float c2 = A.c2;
    bf16x8 qr[8];
#pragma unroll
    for (int d0 = 0; d0 < 8; ++d0) qr[d0] = *(const bf16x8*)(A.Qn + (size_t)qrow * A.ldq + d0 * 16 + hi * 8);
    LAS char* qx = lds + 2 * SHM_V + 2 * KBUF + 2048 + wid * 4608 + r32 * 144 + hi * 16;
    if constexpr (DQK == 192) {
#pragma unroll
        for (int d0 = 0; d0 < 4; ++d0) *(LAS bf16x8*)(qx + d0 * 32) = *(const bf16x8*)(A.Qr + (size_t)qrow * A.ldqr + d0 * 16 + hi * 8);
    }
    const int sr = tid >> 4, sc = (tid & 15) * 8, vst0 = v_st(sr, sc), vst1 = v_st(32 + sr, sc);
    const int vb0 = (int)(unsigned)(size_t)V_lds + v_rd_base(lane);
    const int ntiles = 4 * (qb + 1);
    float m_reg = -1e30f, l_reg = 0.f; f32x16 o[4];
#pragma unroll
    for (int d = 0; d < 4; ++d) o[d] = (f32x16){};
    bf16x8 stk[KPT], stv0, stv1;
#define ATT_LOADT(t, MW) do { const int key0_ = (t) * 64; \
        if constexpr (BITMASK) MW = *(const u32x2*)(A.mask + (size_t)qrow * 64 + 2 * (t));     \
        _Pragma("unroll") for (int i_ = 0; i_ < 2; ++i_) { const int id_ = tid + 512 * i_, row_ = id_ >> 4, c_ = id_ & 15; \
            stk[i_] = *(const bf16x8*)(A.Kn + (size_t)(key0_ + row_) * A.ldk + c_ * 8); } \
        if constexpr (DQK == 192) stk[KPT - 1] = *(const bf16x8*)(A.Kr + (size_t)(key0_ + (tid >> 3)) * A.ldkr + (tid & 7) * 8); \
        stv0 = *(const bf16x8*)(A.V + (size_t)(key0_ + sr) * A.ldv + sc); stv1 = *(const bf16x8*)(A.V + (size_t)(key0_ + 32 + sr) * A.ldv + sc); } while (0)
#define ATT_WRITET(buf) do { \
        _Pragma("unroll") for (int i_ = 0; i_ < 2; ++i_) { const int id_ = tid + 512 * i_, row_ = id_ >> 4, c_ = id_ & 15; \
            *(LAS bf16x8*)(K_lds + (buf) * KBUF + row_ * KROW + c_ * 16) = stk[i_]; } \
        if constexpr (DQK == 192) *(LAS bf16x8*)(K_lds + (buf) * KBUF + (tid >> 3) * KROW + 256 + (tid & 7) * 16) = stk[KPT - 1]; \
        *(LAS bf16x8*)(V_lds + (buf) * SHM_V + vst0) = stv0; *(LAS bf16x8*)(V_lds + (buf) * SHM_V + vst1) = stv1; } while (0)
#define ATT_SUB(t, BUF, SUBT) do { \
        f32x16 p0 = (f32x16){}; \
        const LAS char* kb_ = K_lds + (BUF) * KBUF + (SUBT) * 32 * KROW + r32 * KROW + hi * 16; \
        _Pragma("unroll") for (int d0 = 0; d0 < 8; ++d0) { const bf16x8 k0_ = *(const LAS bf16x8*)(kb_ + d0 * 32); \
            p0 = __builtin_amdgcn_mfma_f32_32x32x16_bf16(k0_, qr[d0], p0, 0, 0, 0); } \
        if constexpr (DQK == 192) { _Pragma("unroll") for (int d0 = 0; d0 < 4; ++d0) { const bf16x8 k0_ = *(const LAS bf16x8*)(kb_ + 256 + d0 * 32); const bf16x8 q_ = *(const LAS bf16x8*)(qx + d0 * 32); \
            p0 = __builtin_amdgcn_mfma_f32_32x32x16_bf16(k0_, q_, p0, 0, 0, 0); } } \
        const float NEG_ = -__builtin_inff(); \
        if constexpr (BITMASK) { const unsigned w0_ = ((SUBT) ? mw.y : mw.x) >> (4 * hi); \
            _Pragma("unroll") for (int r = 0; r < 16; ++r) { const int c_ = (r & 3) + 8 * (r >> 2); if (!((w0_ >> c_) & 1u)) p0[r] = NEG_; } } \
        else { if ((t) * 64 + (SUBT) * 32 + 31 > qlo) { const int dq_ = qrow - (t) * 64 - (SUBT) * 32 - 4 * hi; \
            _Pragma("unroll") for (int r = 0; r < 16; ++r) { const int c_ = (r & 3) + 8 * (r >> 2); if (c_ > dq_) p0[r] = NEG_; } } } \
        float pmax_ = p0[0]; \
        _Pragma("unroll") for (int r = 1; r < 16; ++r) pmax_ = fmaxf(pmax_, p0[r]); \
        { auto rr_ = __builtin_amdgcn_permlane32_swap(__float_as_uint(pmax_), __float_as_uint(pmax_), false, false); pmax_ = fmaxf(__uint_as_float(rr_[0]), __uint_as_float(rr_[1])); } \
        float mn_, alpha_; \
        if (__all((pmax_ - m_reg) * c2 <= 8.f)) { mn_ = m_reg; alpha_ = 1.f; } \
        else { mn_ = fmaxf(m_reg, pmax_); alpha_ = __builtin_amdgcn_exp2f((m_reg - mn_) * c2); m_reg = mn_; } \
        const float mnL_ = -mn_ * c2; \
        _Pragma("unroll") for (int r = 0; r < 16; ++r) p0[r] = __builtin_amdgcn_exp2f(fmaf(p0[r], c2, mnL_)); \
        float ps_ = 0.f; \
        _Pragma("unroll") for (int r = 0; r < 16; ++r) ps_ += p0[r]; \
        { auto rr_ = __builtin_amdgcn_permlane32_swap(__float_as_uint(ps_), __float_as_uint(ps_), false, false); ps_ = __uint_as_float(rr_[0]) + __uint_as_float(rr_[1]); } \
        l_reg = l_reg * alpha_ + ps_; \
        if (__any(alpha_ < 1.f)) { if (hi == 0) al_l[r32] = alpha_; asm volatile("s_waitcnt lgkmcnt(0)" ::: "memory"); \
            _Pragma("unroll") for (int d_ = 0; d_ < 4; ++d_) _Pragma("unroll") for (int r = 0; r < 16; ++r) o[d_][r] *= al_l[crow(r, hi)]; } \
        bf16x8 pa0, pa1; \
        ATT_PK4(p0, 0, pa0); ATT_PK4(p0, 8, pa1); \
        pv_half<BUF, SUBT>(o, vb0, pa0, pa1); } while (0)
#define ATT_COMPUTE(t, BUF, MW) do { if ((t) * 64 <= qlo + 31) { \
        const u32x2 mw = MW; \
        ATT_SUB(t, BUF, 0); \
        if ((t) * 64 + 32 <= qlo + 31) ATT_SUB(t, BUF, 1); } } while (0)
#define ATT_PK4(P, B_, OUT) do { const unsigned a0 = cvt_pk_bf16(P[B_ + 0], P[B_ + 1]), a1 = cvt_pk_bf16(P[B_ + 2], P[B_ + 3]); \
        const unsigned b0 = cvt_pk_bf16(P[B_ + 4], P[B_ + 5]), b1 = cvt_pk_bf16(P[B_ + 6], P[B_ + 7]); \
        auto r0 = __builtin_amdgcn_permlane32_swap(a0, b0, false, false); auto r1 = __builtin_amdgcn_permlane32_swap(a1, b1, false, false); \
        u32x4 w_ = {r0[0], r1[0], r0[1], r1[1]}; OUT = *reinterpret_cast<bf16x8*>(&w_); } while (0)
    u32x2 mwA = {0u, 0u}, mwB = {0u, 0u};
    ATT_LOADT(0, mwA); ATT_WRITET(0); __syncthreads();
    for (int t = 0; t < ntiles; t += 2) {
        ATT_LOADT(t + 1, mwB);
        ATT_COMPUTE(t, 0, mwA);
        ATT_WRITET(1);
        __syncthreads();
        if (t + 2 < ntiles) ATT_LOADT(t + 2, mwA);
        ATT_COMPUTE(t + 1, 1, mwB);
        if (t + 2 < ntiles) ATT_WRITET(0);
        __syncthreads();
    }
#undef ATT_LOADT
#undef ATT_WRITET
#undef ATT_COMPUTE
#undef ATT_PK4
    if (hi == 0) li_l[r32] = l_reg;
    asm volatile("s_waitcnt lgkmcnt(0)" ::: "memory");
    bf16_t* Ow = A.O + (size_t)qlo * A.ldo;
#pragma unroll
    for (int r = 0; r < 16; ++r) { const int orow = crow(r, hi); const float rl = __builtin_amdgcn_rcpf(li_l[orow]);
#pragma unroll
        for (int d0 = 0; d0 < 4; ++d0) { const float v = o[d0][r] * rl; const float vn = __shfl_xor(v, 1);
            if ((r32 & 1) == 0) *(unsigned*)(Ow + (size_t)orow * A.ldo + d0 * 32 + r32) = cvt_pk_bf16(v, vn); } }
    __syncthreads();
}
}

__device__ __forceinline__ void moe_route_wg(const float* LOG, const float* SS, int npart, float* RSTD, const float* bg, const float* be, int* EID, float* WT, unsigned* HIST, int bx, int tid) {
    if (tid >= 64) return;
    const int lane = tid; const bool valid = lane < 32; const int tok = bx * 32 + (lane & 31);
    const float* lr = LOG + (size_t)tok * 64;
    float ssum = 0.f;
    for (int i = 0; i < npart; i += 4) { const f32x4 q = *(const f32x4*)(SS + (size_t)tok * 128 + i); ssum += (q[0] + q[1]) + (q[2] + q[3]); }
    const float rs = rsqrtf(ssum * (1.f / 4096.f) + 1e-6f);
    if (valid) RSTD[tok] = rs;
    float g[4]; float mx = -__builtin_inff();
#pragma unroll
    for (int j = 0; j < 4; ++j) { float s = 0.f;
#pragma unroll
        for (int sp = 0; sp < 8; ++sp) s += lr[(size_t)sp * T * 64 + 32 + j];
        g[j] = s * rs + bg[j]; mx = fmaxf(mx, g[j]); }
    float sum = 0.f; int gs = 0; float gb = g[0];
#pragma unroll
    for (int j = 0; j < 4; ++j) { sum += __expf(g[j] - mx); if (g[j] > gb) { gb = g[j]; gs = j; } }
    const float ggate = __expf(gb - mx) / sum;
    float e[8];
#pragma unroll
    for (int j = 0; j < 8; ++j) { float s = 0.f;
#pragma unroll
        for (int sp = 0; sp < 8; ++sp) s += lr[(size_t)sp * T * 64 + gs * 8 + j];
        e[j] = s * rs + be[gs * 8 + j]; }
    int i0 = 0; float v0 = e[0];
#pragma unroll
    for (int j = 1; j < 8; ++j) if (e[j] > v0) { v0 = e[j]; i0 = j; }
    int i1 = 0; float v1 = -__builtin_inff();
#pragma unroll
    for (int j = 0; j < 8; ++j) if (j != i0 && e[j] > v1) { v1 = e[j]; i1 = j; }
    const float p0 = 1.f, p1 = __expf(v1 - v0);
    const int e0 = gs * 8 + i0, e1 = gs * 8 + i1;
    if (valid) { EID[tok * 2] = e0; EID[tok * 2 + 1] = e1; WT[tok * 2] = ggate * p0 / (p0 + p1); WT[tok * 2 + 1] = ggate * p1 / (p0 + p1); }
    unsigned mine = 0u;
#pragma unroll 4
    for (int ee = 0; ee < NE; ++ee) {
        const unsigned c = (unsigned)__popcll(__ballot(valid && e0 == ee)) + (unsigned)__popcll(__ballot(valid && e1 == ee));
        if (lane == ee) mine = c;
    }
    if (valid) HIST[bx * 32 + lane] = mine;
}

__device__ __forceinline__ void moe_place_wg(LAS unsigned char* tab, const unsigned* HIST, const int* EID, const float* WT, unsigned* CNT, int* PROW, float* WROW,
                                             int bx, int G, int tid) {
    LAS int* rb = (LAS int*)tab;
    LAS int* posl = (LAS int*)tab + 64;
    const int lane = tid & 63;
    LAS int* red = (LAS int*)tab + 128;
    { const int e = tid & 31, wq = tid >> 5; int tot = 0, bef = 0;
#pragma unroll 4
      for (int w = wq; w < G; w += 16) { const int v = (int)HIST[w * 32 + e]; tot += v; bef += (w < bx) ? v : 0; }
      red[(wq * 32 + e) * 2] = tot; red[(wq * 32 + e) * 2 + 1] = bef; }
    __syncthreads();
    if (tid < 64) {
        const int e = lane & 31;
        int tot = 0, bef = 0;
#pragma unroll
        for (int wq = 0; wq < 16; ++wq) { tot += red[(wq * 32 + e) * 2]; bef += red[(wq * 32 + e) * 2 + 1]; }
        const int pad = ((tot + 255) >> 8) << 8;
        int base = 0;
#pragma unroll 4
        for (int j = 0; j < 32; ++j) { const int pj = __shfl(pad, j); base += (j < e) ? pj : 0; }
        if (lane < 32) { rb[e] = base + bef; if (bx == 0) CNT[e] = (unsigned)tot; if (bx == e) { posl[0] = base + tot; posl[1] = base + pad; } }
    }
    __syncthreads();
    if (bx < 32) { const int z0 = posl[0], z1 = posl[1]; for (int r = z0 + tid; r < z1; r += 512) st_wt(PROW + r, 0); }
    __syncthreads();
    if (tid < 64) {
        const bool valid = lane < 32; const int tok = bx * 32 + (lane & 31);
        const int e0 = EID[tok * 2], e1 = EID[tok * 2 + 1];
        int r0 = 0, r1 = 0;
#pragma unroll 4
        for (int tt = 0; tt < 32; ++tt) { const int a0 = __shfl(e0, tt), a1 = __shfl(e1, tt);
            if (tt < lane) { r0 += (a0 == e0) + (a1 == e0); r1 += (a0 == e1) + (a1 == e1); } }
        if (valid) { const int pos0 = rb[e0] + r0, pos1 = rb[e1] + r1;
            posl[2 * lane] = pos0; posl[2 * lane + 1] = pos1;
            st_wt(PROW + pos0, tok * 2); st_wt(PROW + pos1, tok * 2 + 1); st_wt(WROW + pos0, WT[tok * 2]); st_wt(WROW + pos1, WT[tok * 2 + 1]); }
    }
    __syncthreads();
}
__device__ __forceinline__ void combine_row(const bf16_t* xi, const bf16_t* y0, const bf16_t* y1, bf16_t* xo, const float* g, bf16_t* hn, float* fout, float* rs_out, int lane) {
    f32x4 v[16]; float s = 0.f;
#pragma unroll
    for (int j = 0; j < 16; ++j) { const u32x2 x = ((const u32x2*)xi)[lane + 64 * j], a = ((const u32x2*)y0)[lane + 64 * j], b = ((const u32x2*)y1)[lane + 64 * j];
        v[j].x = bf_lo(x.x) + bf_lo(a.x) + bf_lo(b.x); v[j].y = bf_hi(x.x) + bf_hi(a.x) + bf_hi(b.x); v[j].z = bf_lo(x.y) + bf_lo(a.y) + bf_lo(b.y); v[j].w = bf_hi(x.y) + bf_hi(a.y) + bf_hi(b.y);
        s += (v[j].x * v[j].x + v[j].y * v[j].y) + (v[j].z * v[j].z + v[j].w * v[j].w); }
    const float rstd = rsqrtf(wave_sum(s) * (1.f / 4096.f) + 1e-6f);
    if (rs_out) { if (lane == 0) st_wt(rs_out, rstd); }
    if (!hn && !fout) {
#pragma unroll
        for (int j = 0; j < 16; ++j) { u32x2 w; w.x = cvt_pk_bf16(v[j].x, v[j].y); w.y = cvt_pk_bf16(v[j].z, v[j].w); ((u32x2*)xo)[lane + 64 * j] = w; }
        return;
    }
#pragma unroll
    for (int j = 0; j < 16; ++j) { const f32x4 gg = ((const f32x4*)g)[lane + 64 * j];
        if (xo) { u32x2 w; w.x = cvt_pk_bf16(v[j].x, v[j].y); w.y = cvt_pk_bf16(v[j].z, v[j].w); ((u32x2*)xo)[lane + 64 * j] = w; }
        const f32x4 o = {v[j].x * rstd * gg.x, v[j].y * rstd * gg.y, v[j].z * rstd * gg.z, v[j].w * rstd * gg.w};
        if (hn) { u32x2 w; w.x = cvt_pk_bf16(o.x, o.y); w.y = cvt_pk_bf16(o.z, o.w); ((u32x2*)hn)[lane + 64 * j] = w; }
        if (fout) ((f32x4*)fout)[lane + 64 * j] = o; }
}

struct S5In { const float* lre; const float* lim; const float* logdt; const float* bre; const float* bim; const float* cre; const float* cim; const float* dsk; };
__device__ __forceinline__ void cmul(float ar, float ai, float br, float bi, float& cr, float& ci) { cr = ar * br - ai * bi; ci = ar * bi + ai * br; }
template <bool OUT>
__device__ __forceinline__ void s5_unit(LAS char* sl  , const S5In& W, const bf16_t* U, float* ELOC, bf16_t* YG, int b, int g, int ch, int lane) {
    const int n = lane & 31, hi = lane >> 5;
    float a1r[2], a1i[2], a2r[2], a2i[2], a3r[2], a3i[2], a4r[2], a4i[2];
    bf16x8 bfr[4];
    const float dt = __expf(W.logdt[g]);
#pragma unroll
    for (int X = 0; X < 2; ++X) {
        const int p = n + 32 * X, gi = g * S5P + p;
        const float lr = W.lre[gi], li = W.lim[gi];
        const float mag = __expf(lr * dt), ang = li * dt;
        const float are = mag * __cosf(ang), aim = mag * __sinf(ang);
        const float den = lr * lr + li * li, nr = are - 1.f;
        const float fre = (nr * lr + aim * li) / den, fim = (aim * lr - nr * li) / den;
        a1r[X] = are; a1i[X] = aim; cmul(are, aim, are, aim, a2r[X], a2i[X]); cmul(a2r[X], a2i[X], are, aim, a3r[X], a3i[X]); cmul(a2r[X], a2i[X], a2r[X], a2i[X], a4r[X], a4i[X]);
        const f32x4 br0 = *(const f32x4*)(W.bre + (size_t)gi * S5C + 8 * hi), br1 = *(const f32x4*)(W.bre + (size_t)gi * S5C + 8 * hi + 4);
        const f32x4 bi0 = *(const f32x4*)(W.bim + (size_t)gi * S5C + 8 * hi), bi1 = *(const f32x4*)(W.bim + (size_t)gi * S5C + 8 * hi + 4);
        const f32x4 re0 = br0 * fre - bi0 * fim, re1 = br1 * fre - bi1 * fim, im0 = bi0 * fre + br0 * fim, im1 = bi1 * fre + br1 * fim;
        u32x4 wr_ = {cvt_pk_bf16(re0[0], re0[1]), cvt_pk_bf16(re0[2], re0[3]), cvt_pk_bf16(re1[0], re1[1]), cvt_pk_bf16(re1[2], re1[3])};
        u32x4 wi_ = {cvt_pk_bf16(im0[0], im0[1]), cvt_pk_bf16(im0[2], im0[3]), cvt_pk_bf16(im1[0], im1[1]), cvt_pk_bf16(im1[2], im1[3])};
        bfr[2 * X] = *reinterpret_cast<bf16x8*>(&wr_); bfr[2 * X + 1] = *reinterpret_cast<bf16x8*>(&wi_);
    }
    float cr[2] = {0.f, 0.f}, ci[2] = {0.f, 0.f};
    if (OUT && ch > 0) {
#pragma unroll
        for (int X = 0; X < 2; ++X) {
            float pr = a4r[X], pi = a4i[X];
#pragma unroll
            for (int s = 0; s < 6; ++s) { float tr, ti; cmul(pr, pi, pr, pi, tr, ti); pr = tr; pi = ti; }
            const float* el = ELOC + (((size_t)(b * S5G + g) * 8) * S5P + n + 32 * X) * 2;
            for (int j = 0; j < ch; ++j) { const f32x2 e = *(const f32x2*)(el + (size_t)j * S5P * 2); float tr, ti; cmul(pr, pi, cr[X], ci[X], tr, ti); cr[X] = tr + e.x; ci[X] = ti + e.y; }
        }
    }
    bf16x8 cf[4]; f32x4 dsk4 = {0.f, 0.f, 0.f, 0.f};
    const int c16 = lane & 15, q4 = lane >> 4;
    if (OUT) {
#pragma unroll
        for (int ks = 0; ks < 4; ++ks) { const size_t ci_ = ((size_t)g * S5C + c16) * S5P + 16 * ks + 4 * q4;
            const f32x4 xr = *(const f32x4*)(W.cre + ci_), xi = *(const f32x4*)(W.cim + ci_);
            u32x4 w_ = {cvt_pk_bf16(xr[0], -xi[0]), cvt_pk_bf16(xr[1], -xi[1]), cvt_pk_bf16(xr[2], -xi[2]), cvt_pk_bf16(xr[3], -xi[3])};
            cf[ks] = *reinterpret_cast<bf16x8*>(&w_); }
        dsk4 = *(const f32x4*)(W.dsk + g * S5C + 4 * q4);
    }
    const size_t tokc = (size_t)b * SEQ + (size_t)ch * 256;
    bf16x8 ua_n = *(const bf16x8*)(U + (tokc + n) * S5W + g * S5C + 8 * hi);
    u32x2 uu_n0 = {0u, 0u}, uu_n1 = {0u, 0u};
    if (OUT) { uu_n0 = *(const u32x2*)(U + (tokc + c16) * S5W + g * S5C + 4 * q4); uu_n1 = *(const u32x2*)(U + (tokc + 16 + c16) * S5W + g * S5C + 4 * q4); }
#pragma unroll 1
    for (int tl = 0; tl < 8; ++tl) {
        const size_t tok0 = tokc + tl * 32;
        const bf16x8 ua = ua_n; const u32x2 uu_c0 = uu_n0, uu_c1 = uu_n1;
        if (tl + 1 < 8) { const size_t tk1 = tok0 + 32;
            ua_n = *(const bf16x8*)(U + (tk1 + n) * S5W + g * S5C + 8 * hi);
            if (OUT) { uu_n0 = *(const u32x2*)(U + (tk1 + c16) * S5W + g * S5C + 4 * q4); uu_n1 = *(const u32x2*)(U + (tk1 + 16 + c16) * S5W + g * S5C + 4 * q4); } }
        f32x16 acc[4];
#pragma unroll
        for (int k = 0; k < 4; ++k) acc[k] = __builtin_amdgcn_mfma_f32_32x32x16_bf16(ua, bfr[k], (f32x16){}, 0, 0, 0);
#pragma unroll
        for (int X = 0; X < 2; ++X) {
            f32x16& R = acc[2 * X]; f32x16& I = acc[2 * X + 1];
            const float ar = a1r[X], ai = a1i[X];
            float er[4], ei[4];
#pragma unroll
            for (int gq = 0; gq < 4; ++gq) {
#pragma unroll
                for (int k = 1; k < 4; ++k) { const int r = 4 * gq + k; const float pr = R[r - 1], pi = I[r - 1]; R[r] += ar * pr - ai * pi; I[r] += ar * pi + ai * pr; }
                er[gq] = R[4 * gq + 3]; ei[gq] = I[4 * gq + 3];
            }
            float mr[4], mi[4]; float c_r = cr[X], c_i = ci[X];
#pragma unroll
            for (int gq = 0; gq < 4; ++gq) {
                const float or_ = __shfl_xor(er[gq], 32), oi_ = __shfl_xor(ei[gq], 32);
                const float e0r = hi ? or_ : er[gq], e0i = hi ? oi_ : ei[gq];
                const float e1r = hi ? er[gq] : or_, e1i = hi ? ei[gq] : oi_;
                const float c0r = c_r, c0i = c_i; float tr, ti;
                cmul(a4r[X], a4i[X], c_r, c_i, tr, ti); c_r = tr + e0r; c_i = ti + e0i;
                const float c1r = c_r, c1i = c_i;
                cmul(a4r[X], a4i[X], c_r, c_i, tr, ti); c_r = tr + e1r; c_i = ti + e1i;
                mr[gq] = hi ? c1r : c0r; mi[gq] = hi ? c1i : c0i;
            }
            cr[X] = c_r; ci[X] = c_i;
            if (OUT) {
#pragma unroll
                for (int gq = 0; gq < 4; ++gq) {
                    float tr, ti;
                    cmul(a1r[X], a1i[X], mr[gq], mi[gq], tr, ti); R[4 * gq + 0] += tr; I[4 * gq + 0] += ti;
                    cmul(a2r[X], a2i[X], mr[gq], mi[gq], tr, ti); R[4 * gq + 1] += tr; I[4 * gq + 1] += ti;
                    cmul(a3r[X], a3i[X], mr[gq], mi[gq], tr, ti); R[4 * gq + 2] += tr; I[4 * gq + 2] += ti;
                    cmul(a4r[X], a4i[X], mr[gq], mi[gq], tr, ti); R[4 * gq + 3] += tr; I[4 * gq + 3] += ti;
                }
#pragma unroll
                for (int r = 0; r < 16; ++r) { const int row = (r & 3) + 8 * (r >> 2) + 4 * hi;
                    *(LAS unsigned*)(sl + row * 272 + X * 128 + n * 4) = cvt_pk_bf16(R[r], I[r]); }
            }
        }
        if (OUT) {
            asm volatile("s_waitcnt lgkmcnt(0)" ::: "memory");
#pragma unroll
            for (int hf = 0; hf < 2; ++hf) {
                f32x4 y = {0.f, 0.f, 0.f, 0.f};
#pragma unroll
                for (int ks = 0; ks < 4; ++ks) { const bf16x8 sf = *(const LAS bf16x8*)(sl + (16 * hf + c16) * 272 + (32 * ks + 8 * q4) * 2);
                    y = __builtin_amdgcn_mfma_f32_16x16x32_bf16(cf[ks], sf, y, 0, 0, 0); }
                const size_t tk = tok0 + 16 * hf + c16;
                const u32x2 uu = hf ? uu_c1 : uu_c0;
                y[0] += dsk4[0] * bf_lo(uu.x); y[1] += dsk4[1] * bf_hi(uu.x); y[2] += dsk4[2] * bf_lo(uu.y); y[3] += dsk4[3] * bf_hi(uu.y);
#pragma unroll
                for (int i = 0; i < 4; ++i) { const float z = 0.7978845608028654f * (y[i] + 0.044715f * y[i] * y[i] * y[i]); const float th = 1.f - 2.f / (1.f + __expf(2.f * z)); y[i] = 0.5f * y[i] * (1.f + th); }
                st_wt8(YG + tk * S5W + g * S5C + 4 * q4, cvt_pk_bf16(y[0], y[1]), cvt_pk_bf16(y[2], y[3]));
            }
            asm volatile("s_waitcnt lgkmcnt(0)" ::: "memory");
        }
    }
    if (!OUT && hi == 0) {
#pragma unroll
        for (int X = 0; X < 2; ++X) { f32x2 e = {cr[X], ci[X]}; *(f32x2*)(ELOC + (((size_t)(b * S5G + g) * 8 + ch) * S5P + n + 32 * X) * 2) = e; }
    }
}

struct MKArgs { const float* in[27]; float* out; unsigned char* ws; int ph_lo, ph_hi; };
constexpr int NPHASE = 21;

__global__ void __launch_bounds__(512, 2) mk_fwd(MKArgs args) {
    extern __shared__ __attribute__((aligned(16))) unsigned char lds_raw[];
    LAS unsigned char* lds = (LAS unsigned char*)lds_raw;
    const int tid = threadIdx.x, lane = tid & 63, wave = __builtin_amdgcn_readfirstlane(tid >> 6);
    const int G = gridDim.x, bx = blockIdx.x;
    const int gw = bx * 8 + wave, NGW = G * 8;
    volatile LAS unsigned* MISC = (volatile LAS unsigned*)(lds + MISC_OFF);
    if (tid < 32) MISC[tid] = 0u;
    __syncthreads();
    unsigned char* ws = args.ws;
    const int lo = args.ph_lo, hi = args.ph_hi;
    XcdBarrier bar; bar.bar = (unsigned*)(ws + F_CTL) + CW_BAR; bar.x = 0; bar.st = MISC + 8;
    if (hi - lo > 1) bar = xcd_barrier_post((unsigned*)(ws + F_CTL) + CW_BAR, MISC + 8);
#ifndef PHMASK
#define PHMASK 0xffffffffu
#endif
#define IN(k) (((PHMASK >> (k)) & 1u) && lo <= (k) && (k) < hi)
#define SEAM(k) do { if (IN(k) && IN((k) + 1)) xcd_barrier(bar); } while (0)
    constexpr size_t HNS = (size_t)T * 4096;
#define x_in ((const float*)args.in[0])
#define positions ((const int*)args.in[1])
#define norm_mix ((const float*)args.in[2])
#define norm_ffn ((const float*)args.in[3])
#define norm_final ((const float*)args.in[4])
#define BT1 ((bf16_t*)(ws + F_BT1))
#define BT2A ((bf16_t*)(ws + F_BT2A))
#define BT2B ((bf16_t*)(ws + F_BT2B))
#define BT3 ((bf16_t*)(ws + F_BT3))
#define BT4 ((bf16_t*)(ws + F_BT4))
#define BT5 ((bf16_t*)(ws + F_BT5))
#define BTR ((bf16_t*)(ws + F_BTR))
#define BTGU ((bf16_t*)(ws + F_BTGU))
#define BTDN ((bf16_t*)(ws + F_BTDN))
#define HN ((bf16_t*)(ws + F_HN))
#define P ((bf16_t*)(ws + F_P))
#define STQ ((float*)(ws + F_STQ))
#define STKV ((float*)(ws + F_STKV))
#define MASK ((unsigned*)(ws + F_MASK))
#define Q ((bf16_t*)(ws + F_Q))
#define KV ((bf16_t*)(ws + F_KV))
#define CC ((bf16_t*)(ws + F_CC))
#define XBH ((bf16_t*)(ws + F_XB))
#define LOG ((float*)(ws + F_LOG))
#define EID ((int*)(ws + F_EID))
#define WT ((float*)(ws + F_WT))
#define HIST ((unsigned*)(ws + F_HIST))
#define CNT ((unsigned*)(ws + F_CNT))
#define PROW ((int*)(ws + F_PROW))
#define WROW ((float*)(ws + F_WROW))
#define ACT ((bf16_t*)(ws + F_ACT))
#define Y ((bf16_t*)(ws + F_Y))
#define SS ((float*)(ws + F_SS))
#define RSTD ((float*)(ws + F_RSTD))
#define U ((bf16_t*)(ws + F_U))
#define YG ((bf16_t*)(ws + F_YG))
#define ELOC ((float*)(ws + F_ELOC))

#define MOE_CONV(L, I0, I1) MOE_CONV_X(L, I0, I1, gw, NGW)
#define MOE_CONV_X(L, I0, I1, GW_, NGW_) do { for (int id_ = (I0) + (GW_); id_ < (I1); id_ += 4 * (NGW_)) moe_conv4(args.in[25], args.in[26], BTGU, BTDN, norm_ffn + (L) * 4096, (L), id_, (NGW_), (I1), lane); } while (0)
    if (IN(0)) {
        tr_matrix(args.in[5], 4096, PW, BT1, norm_mix, gw, NGW, lane, MapG1{});
        for (int i = gw * 64 + lane; i < (PWF - PW) * 4096 / 8; i += NGW * 64) ((u32x4*)(BT1 + (size_t)PW * 4096))[i] = (u32x4){0u, 0u, 0u, 0u};
        tr_matrix(args.in[8], 1024, 3072, BT2A, args.in[6], gw, NGW, lane, MapUQ{});
        tr_matrix(args.in[9], 512, 4096, BT2B, args.in[7], gw, NGW, lane, MapUKV{});
        tr_matrix(args.in[10], 4096, 4096, BT3, nullptr, gw, NGW, lane, MapId{});
        tr_matrix(args.in[11], 4096, 2048, BT4, norm_mix + 4096, gw, NGW, lane, MapId{});
        tr_matrix(args.in[20], 2048, 8192, BT5, nullptr, gw, NGW, lane, MapPair{4096});
        for (int l = 0; l < 2; ++l) {
            bf16_t* br = BTR + (size_t)l * 256 * 4096;
            for (int i = gw * 64 + lane; i < (256 - 36) * 4096 / 8; i += NGW * 64) ((u32x4*)(br + (size_t)36 * 4096))[i] = (u32x4){0u, 0u, 0u, 0u};
            tr_matrix(args.in[23] + (size_t)l * 4096 * 32, 4096, 32, br, norm_ffn + l * 4096, gw, NGW, lane, MapId{});
            tr_matrix(args.in[21] + (size_t)l * 4096 * 4, 4096, 4, br, norm_ffn + l * 4096, gw, NGW, lane, MapOff{32});
        }
        for (int m = gw; m < T; m += NGW) cast_row_bf16(x_in + (size_t)m * 4096, HN + (size_t)m * 4096, (float*)(ws + F_RS1) + m, lane);
    }
    SEAM(0);
    if (IN(1)) {
        pg::PlainSched S; S.init(HN, 4096 * 2, BT1, 4096, T, PWF, G, bx);
        EpiG1 E{P, STQ, STKV, positions, (const float*)(ws + F_RS1)};
        pg::gemm_phase(lds, 4096, (size_t)4096 * 2, S, E);
        if (G == 256) { if (bx >= 224) MOE_CONV_X(0, 0, 8192, (bx - 224) * 8 + wave, 256); } else MOE_CONV(0, 0, 8192);
    }
    SEAM(1);
    if (IN(2)) {
        { pg::PlainSched S; S.init(P + FC_CQ, PWF * 2, BT2A, 1024, T, 3072, G, bx);
          EpiNormed<16, 1024, 8> E{Q, 3072, STQ, positions};
          pg::gemm_phase(lds, 1024, (size_t)PWF * 2, S, E); }
        { pg::PlainSched S; S.init(P + FC_CKV, PWF * 2, BT2B, 512, T, 4096, G, bx);
          if (G == 256) { if (bx < 128) S.deal(bx, 256, 1); else S.deal(bx, 128, 3); }
          EpiNormed<8, 512, 1000> E{KV, 4096, STKV, positions};
          pg::gemm_phase(lds, 512, (size_t)PWF * 2, S, E); }
        if (wave & 1) MOE_CONV(0, 8192, 32768);
        for (int u = gw; u < 2048; u += NGW) {
            indexer_unit(P, MASK, u >> 10, u & 1023, lane);
            const int u2 = 4095 - u; indexer_unit(P, MASK, u2 >> 10, u2 & 1023, lane);
        }
        if (!(wave & 1)) MOE_CONV(0, 8192, 32768);
    }
    SEAM(2);
    if (IN(3)) {
        for (int it = bx; it < 256; it += G) {
            const int bh = it >> 2, b = bh >> 4, h = bh & 15, xq = it & 3;
            const size_t t0 = (size_t)b * SEQ;
            att::AttPtrs A;
            A.Qn = P + t0 * PWF + FC_QA + h * 128; A.ldq = PWF; A.Qr = nullptr; A.ldqr = 0;
            A.Kn = P + t0 * PWF + FC_KA + (h >> 2) * 128; A.ldk = PWF; A.Kr = nullptr; A.ldkr = 0;
            A.V = P + t0 * PWF + FC_VA + (h >> 2) * 128; A.ldv = PWF; A.O = CC + t0 * 4096 + h * 128; A.ldo = 4096;
            A.mask = MASK + t0 * 64; A.c2 = 0.12751743f;
            if ((bx & 3) == 0) MOE_CONV(0, 32768, 98304);
            att::attn_qblock<128, true>((LAS char*)lds, A, xq);
            if ((bx & 3) == 1) MOE_CONV(0, 32768, 98304);
            att::attn_qblock<128, true>((LAS char*)lds, A, 7 - xq);
        }
        for (int it = bx; it < 256; it += G) {
            const int bh = it >> 2, b = bh >> 4, h = bh & 15, xq = it & 3;
            const size_t t0 = (size_t)b * SEQ;
            att::AttPtrs A;
            A.Qn = Q + t0 * 3072 + h * 128; A.ldq = 3072; A.Qr = Q + t0 * 3072 + 2048 + h * 64; A.ldqr = 3072;
            A.Kn = KV + t0 * 4096 + h * 128; A.ldk = 4096; A.Kr = P + t0 * PWF + FC_KR; A.ldkr = PWF;
            A.V = KV + t0 * 4096 + 2048 + h * 128; A.ldv = 4096; A.O = CC + t0 * 4096 + 2048 + h * 128; A.ldo = 4096;
            A.mask = nullptr; A.c2 = 0.10411707f;
            if ((bx & 3) == 2) MOE_CONV(0, 32768, 98304);
            att::attn_qblock<192, false>((LAS char*)lds, A, xq);
            if ((bx & 3) == 3) MOE_CONV(0, 32768, 98304);
            att::attn_qblock<192, false>((LAS char*)lds, A, 7 - xq);
        }
    }
    SEAM(3);
    if (IN(4)) {
        pg::PlainSched S; S.init(CC, 4096 * 2, BT3, 4096, T, 4096, G, bx);
        EpiRes E{HN, HN + 1 * HNS, SS};
        pg::gemm_phase(lds, 4096, (size_t)4096 * 2, S, E);
    }
    SEAM(4);

#define EARLYQ 4
#define MOE_EARLY(totg, u1dn) int ni_ = ((totg) > G && (totg) < 2 * G) ? 2 * G - (totg) : 0; if (ni_ < 32) ni_ = 0; int ne_ = ni_ * EARLYQ; if (ne_ > (u1dn) || ne_ > 4 * G) { ni_ = 0; ne_ = 0; }
#define MOE_BLOCK(PB, L, NPART, XIN, XOUT, GNEXT, FINAL) do { \
    bf16_t* const HNL = HN + 1 * HNS; float* const LOGL = LOG + (size_t)(L) * 8 * T * 64; float* const SSL = SS + (size_t)(L) * T * 128; float* const RSTDL = RSTD + (size_t)(L) * T; \
    int* const EIDL = EID + (size_t)(L) * NPAIR; float* const WTL = WT + (size_t)(L) * NPAIR; unsigned* const HISTL = HIST + (L) * 256 * 32; unsigned* const CNTL = CNT + (L) * 1024; \
    int* const PROWL = PROW + (size_t)(L) * MAXROWS; float* const WROWL = WROW + (size_t)(L) * MAXROWS; bf16_t* const ACTL = ACT + (size_t)(L) * MAXROWS * 512; bf16_t* const YL = Y; unsigned* const TCL = (unsigned*)(ws + F_CTL + 65536) + (L) * 4096;     \
    if (IN((PB) + 0)) { pg::RouterSched S; S.A = (const char*)HNL; S.B = (const char*)(BTR + (size_t)(L) * 256 * 4096); S.G = G; S.c = bx; EpiLogits E{LOGL}; pg::gemm_phase(lds, 512, (size_t)4096 * 2, S, E, (size_t)4096 * 2); } \
    SEAM((PB) + 0); \
    if (IN((PB) + 1)) { moe_route_wg(LOGL, SSL, (NPART), RSTDL, args.in[22] + (L) * 4, args.in[24] + (L) * 32, EIDL, WTL, HISTL, bx, tid); } \
    SEAM((PB) + 1); \
    if (IN((PB) + 2)) { moe_place_wg(lds + TAB_OFF, HISTL, EIDL, WTL, CNTL, PROWL, WROWL, bx, G, tid); } \
    SEAM((PB) + 2); \
    if (IN((PB) + 3)) { pg::MoeSched S; S.A = (const char*)HNL; S.B = (const char*)(BTGU + (size_t)(L) * 32 * 1024 * 4096); S.cnt = CNTL; S.ldaB = 8192; S.tstepB = (size_t)256 * 4096 * 2; S.bexp = (size_t)1024 * 4096 * 2; S.NT = 4; S.ntsh = 2; S.G = G; S.c = bx; S.gather = 1; S.first = bx; S.step = G; S.lim = 1 << 30; S.load_counts(lds); \
        EpiSilu E{ACTL, PROWL, RSTDL, TCL}; pg::gemm_phase<EpiSilu, pg::MoeSched, true, true>(lds, 4096, (size_t)8192, S, E, 0, PROWL); \
          \
        { const int totg_ = S.total(), u1d_ = 4 * S.u1(); MOE_EARLY(totg_, u1d_); \
          if (ni_ > 0 && bx >= G - ni_) { \
            __syncthreads(); \
            pg::MoeSched S2; S2.A = (const char*)ACTL; S2.B = (const char*)(BTDN + (size_t)(L) * 32 * 4096 * 512); S2.cnt = CNTL; S2.ldaB = 1024; S2.tstepB = (size_t)256 * 512 * 2; S2.bexp = (size_t)4096 * 512 * 2; S2.NT = 16; S2.ntsh = 4; S2.G = G; S2.c = bx; S2.gather = 0; \
            S2.first = bx - (G - ni_); S2.step = ni_; S2.lim = EARLYQ; S2.load_counts(lds); \
            for (int k_ = 0; k_ < EARLYQ; ++k_) { pg::GUnit uu_; const bool ok_ = S2.next(k_, uu_); \
                if (ok_ && tid == 0) { unsigned sp_ = 0; while (xb_ld(TCL + uu_.pm * 32) < 32u) { __builtin_amdgcn_s_sleep(1); if ((++sp_ & 255u) == 0u && (xb_ld(&bar.bar[XB_TMO]) || sp_ > XB_SPIN_CAP)) break; } } } \
            if (tid == 0) { __builtin_amdgcn_fence(__ATOMIC_ACQUIRE, "agent"); asm volatile("s_waitcnt vmcnt(0)" ::: "memory"); } \
            __syncthreads(); \
            EpiDown E2{YL, PROWL, WROWL}; pg::gemm_phase<EpiDown, pg::MoeSched, false, true>(lds, 512, (size_t)1024, S2, E2); } } } \
    SEAM((PB) + 3); \
    if (IN((PB) + 4)) { pg::MoeSched S; S.A = (const char*)ACTL; S.B = (const char*)(BTDN + (size_t)(L) * 32 * 4096 * 512); S.cnt = CNTL; S.ldaB = 1024; S.tstepB = (size_t)256 * 512 * 2; S.bexp = (size_t)4096 * 512 * 2; S.NT = 16; S.ntsh = 4; S.G = G; S.c = bx; S.gather = 0; S.first = bx; S.step = G; S.lim = 1 << 30; S.load_counts(lds); \
        { const int totg_ = S.total() >> 2, u1d_ = S.u1(); MOE_EARLY(totg_, u1d_); S.first = ne_ + bx; }     \
        EpiDown E{YL, PROWL, WROWL}; pg::gemm_phase<EpiDown, pg::MoeSched, false, true>(lds, 512, (size_t)1024, S, E); } \
    SEAM((PB) + 4); \
    if (IN((PB) + 5)) { for (int m = gw; m < T; m += NGW) combine_row((XIN) + (size_t)m * 4096, YL + (size_t)(2 * m) * 4096, YL + (size_t)(2 * m + 1) * 4096, (FINAL) ? nullptr : (XOUT) + (size_t)m * 4096, (GNEXT), \
                                                                    nullptr, (FINAL) ? args.out + (size_t)m * 4096 : nullptr, (FINAL) ? nullptr : (float*)(ws + F_RS4) + m, lane); } \
    SEAM((PB) + 5); } while (0)

    MOE_BLOCK(5, 0, 64, HN + 1 * HNS, XBH, norm_mix + 4096, false);
    if (IN(11)) { pg::PlainSched S; S.init(XBH, 4096 * 2, BT4, 4096, T, 2048, G, bx); EpiBf16R E{U, 2048, (const float*)(ws + F_RS4)}; pg::gemm_phase(lds, 4096, (size_t)4096 * 2, S, E); }
    SEAM(11);
    { S5In W{args.in[12], args.in[13], args.in[14], args.in[15], args.in[16], args.in[17], args.in[18], args.in[19]};
      if (IN(12)) { if (wave & 1) MOE_CONV(1, 0, 32768);
        for (int u = gw; u < 4096; u += NGW) { const int ch = u & 7; if (ch < 7) s5_unit<false>((LAS char*)lds + wave * 8704, W, U, ELOC, YG, u >> 10, (u >> 3) & 127, ch, lane); }
        if (!(wave & 1)) MOE_CONV(1, 0, 32768); }
      SEAM(12);
      if (IN(13)) { if (wave & 1) MOE_CONV(1, 32768, 98304);
        for (int u = gw; u < 4096; u += NGW) s5_unit<true>((LAS char*)lds + wave * 8704, W, U, ELOC, YG, u >> 10, (u >> 3) & 127, u & 7, lane);
        if (!(wave & 1)) MOE_CONV(1, 32768, 98304); }
      SEAM(13); }
    if (IN(14)) { pg::PlainSched S; S.init(YG, 2048 * 2, BT5, 2048, T, 8192, G, bx); EpiGlu E{XBH, HN + 1 * HNS, SS + (size_t)T * 128}; pg::gemm_phase(lds, 2048, (size_t)2048 * 2, S, E); }
    SEAM(14);
    MOE_BLOCK(15, 1, 128, HN + 1 * HNS, XBH, norm_final, true);
#undef MOE_BLOCK
#undef MOE_CONV
#undef x_in
#undef positions
#undef norm_mix
#undef norm_ffn
#undef norm_final
#undef BT1
#undef BT2A
#undef BT2B
#undef BT3
#undef BT4
#undef BT5
#undef BTR
#undef BTGU
#undef BTDN
#undef HN
#undef P
#undef STQ
#undef STKV
#undef MASK
#undef Q
#undef KV
#undef CC
#undef XBH
#undef LOG
#undef EID
#undef WT
#undef HIST
#undef CNT
#undef PROW
#undef WROW
#undef ACT
#undef Y
#undef SS
#undef RSTD
#undef U
#undef YG
#undef ELOC
#undef IN
#undef SEAM
}

#if MODE == 1
struct ViewP { const void* fast; float* orc; double* part; long ldf, ldo; int rows, cols, map, fbf16, inject, fcol0, pad; };
__device__ __forceinline__ int view_map(int map, int c) {
    switch (map) {
        case 1: return MapG1{}(c);
        case 2: return (c < 32) ? 2 * c : 2 * (c - 32) + 1;
        case 3: return MapUQ{}(c);
        case 4: return MapUKV{}(c);
        default: return c;
    }
}
__global__ __launch_bounds__(256) void k_view(ViewP v) {
    __shared__ double shn[256], shd[256];
    double num = 0.0, den = 0.0;
    const long total = (long)v.rows * v.cols;
    for (long i = (long)blockIdx.x * 256 + threadIdx.x; i < total; i += (long)gridDim.x * 256) {
        const long r = i / v.cols; const int c = (int)(i % v.cols);
        const long fo = r * v.ldf + v.fcol0 + view_map(v.map, c);
        const float o = v.orc[r * v.ldo + c];
        if (v.inject) { if (v.fbf16) ((bf16_t*)v.fast)[fo] = (bf16_t)(cvt_pk_bf16(o, 0.f) & 0xffffu); else ((float*)v.fast)[fo] = o; }
        else { const float f = v.fbf16 ? __uint_as_float(((unsigned)((const bf16_t*)v.fast)[fo]) << 16) : ((const float*)v.fast)[fo];
            const double d = (double)f - (double)o; num += d * d; den += (double)o * (double)o; if (!(f == f)) num += 1e30; }
    }
    if (!v.inject) {
        shn[threadIdx.x] = num; shd[threadIdx.x] = den; __syncthreads();
        for (int s = 128; s > 0; s >>= 1) { if (threadIdx.x < s) { shn[threadIdx.x] += shn[threadIdx.x + s]; shd[threadIdx.x] += shd[threadIdx.x + s]; } __syncthreads(); }
        if (threadIdx.x == 0) { v.part[blockIdx.x * 2] = shn[0]; v.part[blockIdx.x * 2 + 1] = shd[0]; }
    }
}
__global__ __launch_bounds__(256) void k_view_mask(unsigned* mask, const unsigned char* sel, double* part, int inject) {
    __shared__ double shn[256], shd[256];
    double num = 0.0, den = 0.0;
    const long total = (long)T * 64;
    for (long i = (long)blockIdx.x * 256 + threadIdx.x; i < total; i += (long)gridDim.x * 256) {
        const long row = i >> 6; const int wd = (int)(i & 63);
        unsigned m = 0u;
        for (int bit = 0; bit < 32; ++bit) m |= (sel[row * SEQ + wd * 32 + bit] ? 1u : 0u) << bit;
        if (inject) mask[i] = m; else { num += (double)__popc(m ^ mask[i]); den += (double)__popc(m); }
    }
    if (!inject) {
        shn[threadIdx.x] = num; shd[threadIdx.x] = den; __syncthreads();
        for (int s = 128; s > 0; s >>= 1) { if (threadIdx.x < s) { shn[threadIdx.x] += shn[threadIdx.x + s]; shd[threadIdx.x] += shd[threadIdx.x + s]; } __syncthreads(); }
        if (threadIdx.x == 0) { part[blockIdx.x * 2] = shn[0]; part[blockIdx.x * 2 + 1] = shd[0]; }
    }
}
constexpr int VIEW_BLOCKS = 1024, MAX_SEAMS = 32;
__device__ __forceinline__ void d_encode(const double* part, int nseams, const float* tol, float* code) {
    if (threadIdx.x != 0 || blockIdx.x != 0) return;
    int k1 = 0, k2 = 0, nact = 0; double e1 = 0.0;
    for (int s = 0; s < nseams; ++s) {
        double num = 0.0, den = 0.0;
        for (int b = 0; b < VIEW_BLOCKS; ++b) { num += part[((long)s * VIEW_BLOCKS + b) * 2]; den += part[((long)s * VIEW_BLOCKS + b) * 2 + 1]; }
        if (!(den > 0.0)) { if (num > 0.0) den = 1e-30; else continue; }
        const double e = num / den; ++nact;
        if (!(e <= (double)tol[s])) { if (k1 == 0) { k1 = s + 1; e1 = e; } else if (k2 == 0) k2 = s + 1; }
    }
    const int mag = (e1 < 1e-3) ? 0 : (e1 < 1e-2) ? 1 : (e1 < 1e-1) ? 2 : 3;
    code[0] = 1.0f + 0.01f * (float)k1;
    code[1] = (k1 == 0) ? (float)nact : (float)(4 * k2 + mag);
}
__global__ void k_apply_code(float* out, const float* code, long n) {
    const float sc = code[0];
    for (long i = (long)blockIdx.x * blockDim.x + threadIdx.x; i < n; i += (long)gridDim.x * blockDim.x) { float v = out[i] * sc; if (i == 0) v += code[1]; out[i] = v; }
}
#endif


extern "C" void kernel_launch(void* const* d_in, const int* in_sizes, int n_in, void* d_out, int out_size, void* d_ws, size_t ws_size, hipStream_t stream) {
    static int inited = 0;
    if (!inited) {
        if (n_in != 27 || (size_t)F_END > ws_size) { fprintf(stderr, "kernel_launch: unexpected n_in %d or workspace %zu < %zu\n", n_in, ws_size, (size_t)F_END); inited = -1; return; }
        if (hipFuncSetAttribute((const void*)mk_fwd, hipFuncAttributeMaxDynamicSharedMemorySize, LDS_BYTES) != hipSuccess) { fprintf(stderr, "kernel_launch: hipFuncSetAttribute failed\n"); inited = -1; return; }
        inited = 1;
    }
    if (inited < 0) return;
    (void)in_sizes; (void)out_size;
    (void)hipMemsetAsync((char*)d_ws + F_CTL, 0, F_CTL_B, stream);
    MKArgs a{};
    for (int i = 0; i < 27; ++i) a.in[i] = (const float*)d_in[i];
    a.out = (float*)d_out; a.ws = (unsigned char*)d_ws; a.ph_lo = 0; a.ph_hi = NPHASE;
    hipLaunchKernelGGL(mk_fwd, dim3(256), dim3(512), LDS_BYTES, stream, a);
}
```

```cpp
#define MODE 2
#include <hip/hip_runtime.h>
#include <stdint.h>
#include <stdio.h>

constexpr int DM = 4096, NB = 4, SEQ = 2048, T = NB * SEQ;
constexpr int PW = 5776;
constexpr int OFF_QA = 0, OFF_KA = 2048, OFF_VA = 2560, OFF_IQ = 3072, OFF_IK = 4096, OFF_IW = 4160, OFF_CQ = 4176, OFF_CKV = 5200, OFF_KR = 5712;
constexpr int NSEL = 256;
constexpr int S5W = 2048, S5G = 128, S5P = 64, S5C = 16;
constexpr int NE = 32, NGRP = 4, EPG = 8, FF = 512, NPAIR = T * 2;


#define GAS __attribute__((address_space(1)))
#define LAS __attribute__((address_space(3)))
typedef unsigned short bf16_t;
typedef short bf16x8 __attribute__((ext_vector_type(8)));
typedef short s16x4 __attribute__((ext_vector_type(4)));
typedef float f32x2 __attribute__((ext_vector_type(2)));
typedef float f32x4 __attribute__((ext_vector_type(4)));
typedef float f32x16 __attribute__((ext_vector_type(16)));
typedef unsigned u32x2 __attribute__((ext_vector_type(2)));
typedef unsigned u32x4 __attribute__((ext_vector_type(4)));
typedef int i32x4 __attribute__((ext_vector_type(4)));
typedef GAS unsigned gu32;
#define RLX_AGENT __ATOMIC_RELAXED, __HIP_MEMORY_SCOPE_AGENT

typedef __bf16 bf16x2_hw __attribute__((ext_vector_type(2)));
__device__ __forceinline__ unsigned cvt_pk_bf16(float lo, float hi) { const f32x2 v = {lo, hi}; const bf16x2_hw b = __builtin_convertvector(v, bf16x2_hw); return __builtin_bit_cast(unsigned, b); }
__device__ __forceinline__ float bf_lo(unsigned w) { return __uint_as_float(w << 16); }
__device__ __forceinline__ float bf_hi(unsigned w) { return __uint_as_float(w & 0xffff0000u); }
__device__ __forceinline__ void st_wt(unsigned* p, unsigned v) { __hip_atomic_store(p, v, __ATOMIC_RELAXED, __HIP_MEMORY_SCOPE_AGENT); }
__device__ __forceinline__ void st_wt(int* p, int v) { __hip_atomic_store(p, v, __ATOMIC_RELAXED, __HIP_MEMORY_SCOPE_AGENT); }
__device__ __forceinline__ void st_wt(float* p, float v) { __hip_atomic_store((unsigned*)p, __float_as_uint(v), __ATOMIC_RELAXED, __HIP_MEMORY_SCOPE_AGENT); }
__device__ __forceinline__ void st_wt8(void* p, unsigned lo, unsigned hi) { __hip_atomic_store((unsigned long long*)p, ((unsigned long long)hi << 32) | lo, __ATOMIC_RELAXED, __HIP_MEMORY_SCOPE_AGENT); }
__device__ __forceinline__ float wave_sum(float v) {
#pragma unroll
    for (int o = 1; o < 64; o <<= 1) v += __shfl_xor(v, o);
    return v;
}

constexpr int PWF = 5888;
constexpr int FC_QA = 0, FC_KA = 2048, FC_VA = 2560, FC_IQ = 3072, FC_CQ = 4096, FC_CKV = 5120, FC_IK = 5632, FC_KR = 5696, FC_IW = 5760;
constexpr int MAXROWS = 24576;
constexpr size_t alz(size_t x) { return (x + 4095) & ~(size_t)4095; }
constexpr size_t F_CTL = 0, F_CTL_B = (size_t)1 << 20;
constexpr size_t F_BT1 = F_CTL + F_CTL_B;                     constexpr size_t F_BT1_B = alz((size_t)PWF * 4096 * 2);
constexpr size_t F_BT2A = F_BT1 + F_BT1_B;                    constexpr size_t F_BT2A_B = alz((size_t)3072 * 1024 * 2);
constexpr size_t F_BT2B = F_BT2A + F_BT2A_B;                  constexpr size_t F_BT2B_B = alz((size_t)4096 * 512 * 2);
constexpr size_t F_BT3 = F_BT2B + F_BT2B_B;                   constexpr size_t F_BT3_B = alz((size_t)4096 * 4096 * 2);
constexpr size_t F_BT4 = F_BT3 + F_BT3_B;                     constexpr size_t F_BT4_B = alz((size_t)2048 * 4096 * 2);
constexpr size_t F_BT5 = F_BT4 + F_BT4_B;                     constexpr size_t F_BT5_B = alz((size_t)8192 * 2048 * 2);
constexpr size_t F_BTR = F_BT5 + F_BT5_B;                     constexpr size_t F_BTR_B = alz((size_t)2 * 256 * 4096 * 2);
constexpr size_t F_BTGU = F_BTR + F_BTR_B;                    constexpr size_t F_BTGU_B = alz((size_t)2 * 32 * 1024 * 4096 * 2);
constexpr size_t F_BTDN = F_BTGU + F_BTGU_B;                  constexpr size_t F_BTDN_B = alz((size_t)2 * 32 * 4096 * 512 * 2);
constexpr size_t F_HN = F_BTDN + F_BTDN_B;                    constexpr size_t F_HN_B = 2 * alz((size_t)T * 4096 * 2);
constexpr size_t F_P = F_HN + F_HN_B;                         constexpr size_t F_P_B = alz((size_t)T * PWF * 2);
constexpr size_t F_STQ = F_P + F_P_B;                         constexpr size_t F_STQ_B = alz((size_t)T * 16 * 4);
constexpr size_t F_STKV = F_STQ + F_STQ_B;                    constexpr size_t F_STKV_B = alz((size_t)T * 8 * 4);
constexpr size_t F_MASK = F_STKV + F_STKV_B;                  constexpr size_t F_MASK_B = alz((size_t)T * 64 * 4);
constexpr size_t F_Q = F_MASK + F_MASK_B;                     constexpr size_t F_Q_B = alz((size_t)T * 3072 * 2);
constexpr size_t F_KV = F_Q + F_Q_B;                          constexpr size_t F_KV_B = alz((size_t)T * 4096 * 2);
constexpr size_t F_CC = F_KV + F_KV_B;                        constexpr size_t F_CC_B = alz((size_t)T * 4096 * 2);
constexpr size_t F_XA = F_CC + F_CC_B;                        constexpr size_t F_XA_B = alz((size_t)T * 4096 * 4);
constexpr size_t F_XB = F_XA + F_XA_B;                        constexpr size_t F_XB_B = alz((size_t)T * 4096 * 4);
constexpr size_t F_LOG = F_XB + F_XB_B;                       constexpr size_t F_LOG_B = 2 * alz((size_t)8 * T * 64 * 4);
constexpr size_t F_EID = F_LOG + F_LOG_B;                     constexpr size_t F_EID_B = 2 * alz((size_t)NPAIR * 4);
constexpr size_t F_WT = F_EID + F_EID_B;                      constexpr size_t F_WT_B = 2 * alz((size_t)NPAIR * 4);
constexpr size_t F_HIST = F_WT + F_WT_B;                      constexpr size_t F_HIST_B = 2 * alz((size_t)256 * 32 * 4);
constexpr size_t F_CNT = F_HIST + F_HIST_B;                   constexpr size_t F_CNT_B = 2 * 4096;
constexpr size_t F_PROW = F_CNT + F_CNT_B;                    constexpr size_t F_PROW_B = 2 * alz((size_t)MAXROWS * 4);
constexpr size_t F_WROW = F_PROW + F_PROW_B;                  constexpr size_t F_WROW_B = 2 * alz((size_t)MAXROWS * 4);
constexpr size_t F_AG = F_WROW + F_WROW_B;                    constexpr size_t F_AG_B = 4096;
constexpr size_t F_ACT = F_AG + F_AG_B;                       constexpr size_t F_ACT_B = 2 * alz((size_t)MAXROWS * 512 * 2);
constexpr size_t F_Y = F_ACT + F_ACT_B;                       constexpr size_t F_Y_B = alz((size_t)NPAIR * 4096 * 2);
constexpr size_t F_U = F_Y + F_Y_B;                           constexpr size_t F_U_B = alz((size_t)T * 2048 * 2);
constexpr size_t F_YG = F_U + F_U_B;                          constexpr size_t F_YG_B = alz((size_t)T * 2048 * 2);
constexpr size_t F_ELOC = F_YG + F_YG_B;                      constexpr size_t F_ELOC_B = alz((size_t)NB * S5G * 8 * S5P * 2 * 4);
constexpr size_t F_SS = F_ELOC + F_ELOC_B;                    constexpr size_t F_SS_B = 2 * alz((size_t)T * 128 * 4);
constexpr size_t F_RSTD = F_SS + F_SS_B;                      constexpr size_t F_RSTD_B = 2 * alz((size_t)T * 4);
constexpr size_t F_RS4 = F_RSTD + F_RSTD_B;                   constexpr size_t F_RS4_B = alz((size_t)T * 4);
constexpr size_t F_RS1 = F_RS4 + F_RS4_B;                     constexpr size_t F_RS1_B = alz((size_t)T * 4);
constexpr size_t F_END = F_RS1 + F_RS1_B;

constexpr int CW_TMO = 0, CW_BAR = 4096;
constexpr int LDS_BYTES = 147456;
constexpr int MISC_OFF = 131072 + 8192;
constexpr int TAB_OFF = 131072;

#define XB_TMO      128
#define XB_XCNT(j)  (256  + 64 * (j))
#define XB_XSUB(j)  (1280 + 64 * (j))
#define XB_XGEN(j)  (2304 + 64 * (j))
#define XB_TOP      3328
#define XB_TOPGEN   3392
#define XCD_BAR_WORDS 3456
#define XB_SPIN_CAP (1u << 18)
__device__ __forceinline__ unsigned xb_ld(unsigned* p)              { return __hip_atomic_load(p, __ATOMIC_RELAXED, __HIP_MEMORY_SCOPE_AGENT); }
__device__ __forceinline__ unsigned xb_add(unsigned* p, unsigned v) { return __hip_atomic_fetch_add(p, v, __ATOMIC_RELAXED, __HIP_MEMORY_SCOPE_AGENT); }
__device__ __forceinline__ unsigned xb_xcc_id() { return (unsigned)__builtin_amdgcn_s_getreg((3 << 11) | 20) & 0xFu; }
#define XB_SPIN(cond, bar) do { unsigned _sp = 0; while (cond) { __builtin_amdgcn_s_sleep(1); \
    if ((++_sp & 255u) == 0u) { if (xb_ld(&(bar)[XB_TMO])) break; if (_sp > XB_SPIN_CAP) { atomicAdd(&(bar)[XB_TMO], 1u); break; } } } } while (0)
struct XcdBarrier { unsigned* bar; unsigned x; volatile LAS unsigned* st; };
__device__ __forceinline__ XcdBarrier xcd_barrier_post(unsigned* bar, volatile LAS unsigned* st) {
    XcdBarrier b; b.bar = bar; b.x = xb_xcc_id(); b.st = st;
    if (threadIdx.x == 0) (void)xb_add(&bar[XB_XCNT(b.x)], 1u);
    return b;
}
__device__ __forceinline__ void xcd_barrier_complete(unsigned* bar, unsigned x, unsigned& nloc, unsigned& nx) {
    const unsigned G = gridDim.x * gridDim.y * gridDim.z;
    unsigned sum, cnt, mine, sp = 0u;
    for (;;) {
        sum = 0u; cnt = 0u; mine = 0u;
#pragma unroll
        for (unsigned j = 0; j < 16; ++j) { const unsigned c = xb_ld(&bar[XB_XCNT(j)]); sum += c; cnt += (c > 0u) ? 1u : 0u; mine = (j == x) ? c : mine; }
        if (sum == G) break;
        __builtin_amdgcn_s_sleep(1);
        if ((++sp & 255u) == 0u) { if (xb_ld(&bar[XB_TMO])) break; if (sp > XB_SPIN_CAP) { atomicAdd(&bar[XB_TMO], 1u); break; } }
    }
    nloc = mine > 0u ? mine : 1u; nx = cnt > 0u ? cnt : 1u;
}
__device__ __forceinline__ void xcd_barrier(const XcdBarrier& b) {
    asm volatile("s_waitcnt vmcnt(0)" ::: "memory");
    __syncthreads();
    if (threadIdx.x == 0) {
        unsigned* bar = b.bar;
        __builtin_amdgcn_s_waitcnt(0);
        unsigned nloc = b.st[0], nx = b.st[1];
        if (nloc == 0u) { xcd_barrier_complete(bar, b.x, nloc, nx); b.st[0] = nloc; b.st[1] = nx; }
        const unsigned old = xb_add(&bar[XB_XSUB(b.x)], 1u);
        const unsigned gen = old / nloc;
        if (old + 1u == (gen + 1u) * nloc) {
            __builtin_amdgcn_fence(__ATOMIC_RELEASE, "agent");
            asm volatile("s_waitcnt vmcnt(0)" ::: "memory");
            const unsigned og = xb_add(&bar[XB_TOP], 1u);
            const unsigned tg = og / nx;
            if (og + 1u == (tg + 1u) * nx) xb_add(&bar[XB_TOPGEN], 1u);
            else XB_SPIN(xb_ld(&bar[XB_TOPGEN]) == tg, bar);
            __builtin_amdgcn_fence(__ATOMIC_ACQUIRE, "agent");
            xb_add(&bar[XB_XGEN(b.x)], 1u);
            asm volatile("s_waitcnt vmcnt(0)" ::: "memory");
        } else {
            XB_SPIN(xb_ld(&bar[XB_XGEN(b.x)]) == gen, bar);
            __builtin_amdgcn_fence(__ATOMIC_ACQUIRE, "agent");
            asm volatile("s_waitcnt vmcnt(0)" ::: "memory");
        }
    }
    __syncthreads();
}

struct MapId   { __device__ __forceinline__ int operator()(int n) const { return n; } };
struct MapG1   { __device__ __forceinline__ int operator()(int n) const {
    if (n < 4096) return n;
    if (n < 4160) return FC_IK + (n - 4096);
    if (n < 4176) return FC_IW + (n - 4160);
    if (n < 5200) return FC_CQ + (n - 4176);
    if (n < 5712) return FC_CKV + (n - 5200);
    const int i = n - 5712; return FC_KR + ((i < 32) ? 2 * i : 2 * (i - 32) + 1); } };
struct MapUQ   { __device__ __forceinline__ int operator()(int n) const { const int h = n / 192, d = n % 192;
    if (d < 128) return h * 128 + d; const int i = d - 128; return 2048 + h * 64 + ((i < 32) ? 2 * i : 2 * (i - 32) + 1); } };
struct MapUKV  { __device__ __forceinline__ int operator()(int n) const { const int h = n >> 8, d = n & 255; return (d < 128) ? h * 128 + d : 2048 + h * 128 + (d - 128); } };
struct MapPair { int half; __device__ __forceinline__ int operator()(int n) const { const int hi = n >= half, j = hi ? n - half : n; return (j >> 7) * 256 + hi * 128 + (j & 127); } };
struct MapOff  { int off; __device__ __forceinline__ int operator()(int n) const { return n + off; } };

template <class Map>
__device__ __forceinline__ void tr_item(const float* __restrict__ W, int K, int N, bf16_t* WT, const float* __restrict__ kscale, int item, int lane, const Map& map) {
    const int nblk = (N + 31) >> 5, kb = item / nblk, nb = item - kb * nblk;
    const int c = lane & 7, nq = lane >> 3;
    const int k0 = kb * 64 + 8 * c, n = nb * 32 + 4 * nq;
    if (n < N) {
        f32x4 v[8];
#pragma unroll
        for (int i = 0; i < 8; ++i) v[i] = *(const f32x4*)(W + (size_t)(k0 + i) * N + n);
        if (kscale) {
#pragma unroll
            for (int i = 0; i < 8; ++i) v[i] *= kscale[k0 + i];
        }
#pragma unroll
        for (int j = 0; j < 4; ++j) {
            u32x4 o; o.x = cvt_pk_bf16(v[0][j], v[1][j]); o.y = cvt_pk_bf16(v[2][j], v[3][j]); o.z = cvt_pk_bf16(v[4][j], v[5][j]); o.w = cvt_pk_bf16(v[6][j], v[7][j]);
            *(u32x4*)(WT + (size_t)map(n + j) * K + k0) = o;
        }
    }
}
__device__ __forceinline__ void moe_conv4(const float* __restrict__ Wgu, const float* __restrict__ Wdn, bf16_t* Tgu, bf16_t* Tdn, const float* __restrict__ ks, int L, int id0, int step, int end, int lane) {
    const int c = lane & 7, nq = lane >> 3;
    f32x4 v[4][8], kv[4][2];
#pragma unroll
    for (int b = 0; b < 4; ++b) {
        const int id = id0 + b * step;
        if (id < end) {
            const int e = id / 3072, j = id - e * 3072, le = L * 32 + e; const bool gu = j < 2048; const int jj = gu ? j : j - 2048;
            const int N = gu ? 1024 : 4096, kb = gu ? (jj >> 5) : (jj >> 7), nb = gu ? (jj & 31) : (jj & 127), k0 = kb * 64 + 8 * c;
            const float* src = (gu ? Wgu + (size_t)le * 4096 * 1024 : Wdn + (size_t)le * 512 * 4096) + (size_t)k0 * N + nb * 32 + 4 * nq;
#pragma unroll
            for (int i = 0; i < 8; ++i) v[b][i] = __builtin_nontemporal_load((const f32x4*)(src + (size_t)i * N));
            if (gu) { kv[b][0] = *(const f32x4*)(ks + k0); kv[b][1] = *(const f32x4*)(ks + k0 + 4); }
        }
    }
#pragma unroll
    for (int b = 0; b < 4; ++b) {
        const int id = id0 + b * step;
        if (id < end) {
            const int e = id / 3072, j = id - e * 3072, le = L * 32 + e; const bool gu = j < 2048; const int jj = gu ? j : j - 2048;
            const int K = gu ? 4096 : 512, kb = gu ? (jj >> 5) : (jj >> 7), nb = gu ? (jj & 31) : (jj & 127), k0 = kb * 64 + 8 * c, n = nb * 32 + 4 * nq;
            if (gu) {
#pragma unroll
                for (int i = 0; i < 8; ++i) v[b][i] *= kv[b][i >> 2][i & 3];
            }
            bf16_t* dst = (gu ? Tgu + (size_t)le * 1024 * 4096 : Tdn + (size_t)le * 4096 * 512) + k0;
#pragma unroll
            for (int q = 0; q < 4; ++q) {
                u32x4 o; o.x = cvt_pk_bf16(v[b][0][q], v[b][1][q]); o.y = cvt_pk_bf16(v[b][2][q], v[b][3][q]); o.z = cvt_pk_bf16(v[b][4][q], v[b][5][q]); o.w = cvt_pk_bf16(v[b][6][q], v[b][7][q]);
                const int row = gu ? MapPair{512}(n + q) : n + q;
                __builtin_nontemporal_store(o, (u32x4*)(dst + (size_t)row * K));
            }
        }
    }
}
template <class Map>
__device__ __forceinline__ void tr_matrix(const float* W, int K, int N, bf16_t* WT, const float* kscale, int gw, int NGW, int lane, const Map& map) {
    const int nitems = (K >> 6) * ((N + 31) >> 5);
    for (int it = gw; it < nitems; it += NGW) tr_item(W, K, N, WT, kscale, it, lane, map);
}
__device__ __forceinline__ void cast_row_bf16(const float* xrow, bf16_t* orow, float* rs_out, int lane) {
    f32x4 v[16]; float s = 0.f;
#pragma unroll
    for (int j = 0; j < 16; ++j) { v[j] = ((const f32x4*)xrow)[lane + 64 * j]; s += (v[j].x * v[j].x + v[j].y * v[j].y) + (v[j].z * v[j].z + v[j].w * v[j].w); }
#pragma unroll
    for (int j = 0; j < 16; ++j) { u32x2 o; o.x = cvt_pk_bf16(v[j].x, v[j].y); o.y = cvt_pk_bf16(v[j].z, v[j].w); ((u32x2*)orow)[lane + 64 * j] = o; }
    const float rstd = rsqrtf(wave_sum(s) * (1.f / 4096.f) + 1e-6f);
    if (lane == 0) st_wt(rs_out, rstd);
}
__device__ __forceinline__ void norm_row_bf16(const float* xrow, const float* g, bf16_t* orow, int lane) {
    f32x4 v[16]; float s = 0.f;
#pragma unroll
    for (int j = 0; j < 16; ++j) { v[j] = ((const f32x4*)xrow)[lane + 64 * j]; s += (v[j].x * v[j].x + v[j].y * v[j].y) + (v[j].z * v[j].z + v[j].w * v[j].w); }
    const float rstd = rsqrtf(wave_sum(s) * (1.f / 4096.f) + 1e-6f);
#pragma unroll
    for (int j = 0; j < 16; ++j) { const f32x4 gg = ((const f32x4*)g)[lane + 64 * j];
        u32x2 o; o.x = cvt_pk_bf16(v[j].x * rstd * gg.x, v[j].y * rstd * gg.y); o.y = cvt_pk_bf16(v[j].z * rstd * gg.z, v[j].w * rstd * gg.w);
        ((u32x2*)orow)[lane + 64 * j] = o; }
}

namespace pg {
constexpr int BM = 256, BK = 64, HALF = 128, HTB = HALF * BK * 2, STAGE_BYTES = 8 * HTB, NXCD = 8, WGM = 8;
__host__ __device__ __forceinline__ int lds_byte(int r, int c) { const int st = (r >> 4) * 2 + (c >> 5), rr = r & 15, cc = c & 31, ob = rr * 64 + cc * 2; return st * 1024 + (ob ^ (((ob >> 9) & 1) << 5)); }
__host__ __device__ __forceinline__ void stage_rc(int b, int& R, int& C) { const int st = b / 1024, sb = b % 1024, swz = sb ^ (((sb >> 9) & 1) << 5); R = (st >> 1) * 16 + swz / 64; C = (st & 1) * 32 + (swz % 64) / 2; }
struct GUnit { const char* A; const char* B; int pm, pn, e, rows; };
#define EPI_ARGS const f32x4 (&acc)[2][2][4][2], const pg::GUnit& u, int wr, int wc, int fr, int fq

struct PlainSched {
    const char* A; const char* B; size_t tstepA, tstepB; int nM, nN, nwg, G, c, cnt;
    __device__ __forceinline__ void init(const void* A_, size_t ldaB, const void* B_, int K, int M, int N, int G_, int c_) {
        A = (const char*)A_; B = (const char*)B_; tstepA = 256 * ldaB; tstepB = (size_t)256 * K * 2; nM = M / BM; nN = N / BM; nwg = nM * nN; G = G_; c = c_; cnt = 1 << 30; }
    __device__ __forceinline__ void deal(int first, int step, int count) { c = first; G = step; cnt = count; }
    __device__ __forceinline__ bool next(int i, GUnit& u) const {
        const long L = (long)i * G + c; if (L >= nwg || i >= cnt) return false;
        int wgid = (int)L; { const int q = nwg / NXCD, r = nwg % NXCD, xcd = wgid % NXCD, off = wgid / NXCD; wgid = (xcd < r ? xcd * (q + 1) : r * (q + 1) + (xcd - r) * q) + off; }
        const int nig = WGM * nN, gid = wgid / nig, fm = gid * WGM, gsz = (nM - fm) < WGM ? (nM - fm) : WGM;
        u.pm = fm + ((wgid % nig) % gsz); u.pn = (wgid % nig) / gsz; u.e = 0; u.rows = 256;
        u.A = A + (size_t)u.pm * tstepA; u.B = B + (size_t)u.pn * tstepB; return true;
    }
};
struct RouterSched {
    const char* A; const char* B; int G, c;
    __device__ __forceinline__ bool next(int i, GUnit& u) const {
        const int L = i * G + c; if (L >= 256) return false;
        u.pm = L >> 3; u.pn = L & 7; u.e = 0; u.rows = 256;
        u.A = A + (size_t)u.pm * 256 * 8192 + (size_t)u.pn * 1024; u.B = B + (size_t)u.pn * 1024; return true;
    }
};
struct MoeSched {
    const char* A; const char* B; const unsigned* cnt; size_t ldaB, tstepB, bexp; int NT, ntsh, G, c; int gather; int first, step, lim; LAS const unsigned char* tab;
    __device__ __forceinline__ void load_counts(LAS unsigned char* lds) {
        tab = lds + TAB_OFF;
        if (threadIdx.x < 64) {
            const int l = threadIdx.x & 63;
            const int n = (int)__hip_atomic_load(cnt + (l & 31), RLX_AGENT);
            const int mf = n >> 8, rem = n & 255;
            int u1 = (mf + (rem > 128 ? 1 : 0)) * NT, u2 = (rem > 0 && rem <= 128) ? NT : 0, pd = ((n + 255) >> 8) * 256;
            if (l >= 32) { u1 = 0; u2 = 0; pd = 0; }
            int s1 = u1, s2 = u2, sp = pd;
#pragma unroll
            for (int d = 1; d < 32; d <<= 1) { const int t1 = __shfl_up(s1, d), t2 = __shfl_up(s2, d), tp = __shfl_up(sp, d); if (l >= d) { s1 += t1; s2 += t2; sp += tp; } }
            const int tot1 = __shfl(s1, 31), tot2 = __shfl(s2, 31);
            if (l < 32) *(LAS i32x4*)(lds + TAB_OFF + l * 16) = (i32x4){s1 - u1, tot1 + s2 - u2, sp - pd, n};
            if (l == 32) *(LAS i32x4*)(lds + TAB_OFF + 32 * 16) = (i32x4){tot1, tot2, 0, 0};
        }
        __syncthreads();
    }
    __device__ __forceinline__ int total() const { const i32x4 g = *(LAS const i32x4*)(tab + 32 * 16); return __builtin_amdgcn_readfirstlane(g.x + g.y); }
    __device__ __forceinline__ int u1() const { const i32x4 g = *(LAS const i32x4*)(tab + 32 * 16); return __builtin_amdgcn_readfirstlane(g.x); }
    __device__ __forceinline__ bool next(int i, GUnit& u) const {
        if (i >= lim) return false;
        const int L = first + i * step;
        const i32x4 t = *(LAS const i32x4*)(tab + (threadIdx.x & 31) * 16);
        const int n = t.w, mf = n >> 8, rem = n & 255;
        const int u1 = (mf + (rem > 128 ? 1 : 0)) * NT, u2 = (rem > 0 && rem <= 128) ? NT : 0;
        const unsigned long long m1 = __ballot(L >= t.x && L < t.x + u1), m2 = __ballot(L >= t.y && L < t.y + u2);
        if ((m1 | m2) == 0ull) return false;
        const bool p1 = m1 != 0ull;
        const int e = __builtin_ctzll(p1 ? m1 : m2);
        const int ne = __builtin_amdgcn_readlane(n, e), rowbase = __builtin_amdgcn_readlane(t.z, e);
        const int loc = L - (p1 ? __builtin_amdgcn_readlane(t.x, e) : __builtin_amdgcn_readlane(t.y, e));
        const int mfe = ne >> 8, reme = ne & 255;
        const int m = p1 ? (loc >> ntsh) : mfe, nt = p1 ? (loc & (NT - 1)) : loc;
        u.pm = (rowbase >> 8) + m; u.pn = nt; u.e = e; u.rows = (m < mfe) ? 256 : reme;
        u.A = gather ? A : A + (size_t)(rowbase + m * 256) * ldaB; u.B = B + (size_t)e * bexp + (size_t)nt * tstepB; return true;
    }
};

template <class Epi, class Sched, bool GATHER = false, bool SKIPDEAD = false>
__device__ __forceinline__ void gemm_phase(LAS unsigned char* lds, const int K, const size_t ldaB, const Sched& S, const Epi& E, const size_t ldbB_ = 0, const int* rowtab = nullptr) {
    int tid = threadIdx.x; asm volatile("" : "+v"(tid));
    const int wid = __builtin_amdgcn_readfirstlane(tid >> 6), lane = tid & 63, wr = wid >> 2, wc = wid & 3, fr = lane & 15, fq = lane >> 4;
    const int nt = K / BK; const size_t ldbB = ldbB_ ? ldbB_ : (size_t)K * 2;
    unsigned voffA[2], voffB[2]; int gR[2], gC[2];
#pragma unroll
    for (int i = 0; i < 2; ++i) { int R, C; stage_rc(tid * 16 + i * 8192, R, C); gR[i] = R; gC[i] = C * 2; voffA[i] = (unsigned)(R * ldaB + C * 2); voffB[i] = (unsigned)(R * ldbB + C * 2); }
    unsigned gcur[2][2], gnxt[2][2];
#define PG_GOFF(dst, uu) do { _Pragma("unroll") for (int h_ = 0; h_ < 2; ++h_) _Pragma("unroll") for (int i_ = 0; i_ < 2; ++i_) \
        dst[h_][i_] = (unsigned)(rowtab[(uu).pm * 256 + h_ * 128 + gR[i_]] >> 1) * (unsigned)ldaB + (unsigned)gC[i_]; } while (0)
    const size_t kstep = (size_t)(BK * 2);
    const size_t hstepA = (size_t)HALF * ldaB, hstepB = (size_t)HALF * ldbB;
    const unsigned ldsw = (unsigned)wid * 1024u;
    const int aoff = lds_byte(wr * 64 + fr, fq * 8), boff = lds_byte(wc * 32 + fr, fq * 8);
#define PG_SA(b, h) (((b) * 2 + (h)) * HTB)
#define PG_SB(b, h) ((4 + (b) * 2 + (h)) * HTB)
#define PG_STAGE(bufoff, gbase, voff) do { _Pragma("unroll") for (int _i = 0; _i < 2; ++_i) \
        __builtin_amdgcn_global_load_lds((const unsigned*)((const char*)(gbase) + (voff)[_i]), (LAS unsigned*)(lds + (bufoff) + ldsw + _i * 8192), 16, 0, 0); } while (0)
#define PG_STAGE_A(bufoff, gbase, h, isnext) do { if constexpr (GATHER) { _Pragma("unroll") for (int _i = 0; _i < 2; ++_i) \
        __builtin_amdgcn_global_load_lds((const unsigned*)((const char*)(gbase) + ((isnext) ? gnxt[h][_i] : gcur[h][_i])), (LAS unsigned*)(lds + (bufoff) + ldsw + _i * 8192), 16, 0, 0); } \
        else { PG_STAGE(bufoff, (gbase) + (h) * hstepA, voffA); } } while (0)
#define PG_LDA(dst, b, h) do { _Pragma("unroll") for (int m = 0; m < 4; ++m) _Pragma("unroll") for (int k = 0; k < 2; ++k) dst[m][k] = *(const LAS bf16x8*)(lds + PG_SA(b, h) + aoff + m * 2048 + k * 1024); } while (0)
#define PG_LDB(dst, b, h) do { _Pragma("unroll") for (int n = 0; n < 2; ++n) _Pragma("unroll") for (int k = 0; k < 2; ++k) dst[n][k] = *(const LAS bf16x8*)(lds + PG_SB(b, h) + boff + n * 2048 + k * 1024); } while (0)
#define PG_MMA(ai, bj, At, Bt) do { __builtin_amdgcn_s_setprio(1); _Pragma("unroll") for (int m = 0; m < 4; ++m) _Pragma("unroll") for (int n = 0; n < 2; ++n) _Pragma("unroll") for (int k = 0; k < 2; ++k) \
        acc[ai][bj][m][n] = __builtin_amdgcn_mfma_f32_16x16x32_bf16(Bt[n][k], At[m][k], acc[ai][bj][m][n], 0, 0, 0); __builtin_amdgcn_s_setprio(0); } while (0)
#define PG_WAIT_V(n) asm volatile("s_waitcnt vmcnt(" #n ")" ::: "memory")
#define PG_WAIT_L(n) asm volatile("s_waitcnt lgkmcnt(" #n ")" ::: "memory")
#define PG_BAR __builtin_amdgcn_s_barrier()
#define PG_SCHED __builtin_amdgcn_sched_barrier(0)
    GUnit cur, nxt; int ui = 0;
    if (!S.next(0, cur)) return;
    f32x4 acc[2][2][4][2];
#pragma unroll
    for (int a = 0; a < 2; ++a)
#pragma unroll
        for (int b = 0; b < 2; ++b)
#pragma unroll
            for (int m = 0; m < 4; ++m)
#pragma unroll
                for (int n = 0; n < 2; ++n) acc[a][b][m][n] = (f32x4){0.f, 0.f, 0.f, 0.f};
    bf16x8 At[4][2], B0[2][2], B1[2][2];
    const char* cA = cur.A; const char* cB = cur.B;
    if constexpr (GATHER) { PG_GOFF(gcur, cur); }
    PG_STAGE(PG_SB(0, 0), cB, voffB); PG_STAGE(PG_SB(0, 1), cB + hstepB, voffB); PG_STAGE_A(PG_SA(0, 0), cA, 0, false); PG_STAGE_A(PG_SA(0, 1), cA, 1, false);
    if (wr == 1) PG_BAR;
    PG_WAIT_V(2); PG_BAR;
    PG_STAGE(PG_SB(1, 0), cB + kstep, voffB); PG_STAGE_A(PG_SA(1, 0), cA + kstep, 0, false); PG_STAGE(PG_SB(1, 1), cB + hstepB + kstep, voffB);
    PG_WAIT_V(6); PG_BAR;
    for (;;) {
        const bool has_next = S.next(ui + 1, nxt);
        const char* nA = has_next ? nxt.A : cA; const char* nB = has_next ? nxt.B : cB;
        if constexpr (GATHER) { if (has_next) { PG_GOFF(gnxt, nxt); } }
        const bool live1 = !SKIPDEAD || cur.rows > 128;
        for (int t = 0; t < nt; t += 2) {
            const bool last = (t == nt - 2); const bool nx_ = last && has_next;
            const char* a1 = cA + (size_t)(t + 1) * kstep;
            const char* a2 = last ? nA : cA + (size_t)(t + 2) * kstep; const char* b2 = last ? nB : cB + (size_t)(t + 2) * kstep;
            const char* a3 = a2 + kstep; const char* b3 = b2 + kstep;
            PG_LDB(B0, 0, 0); PG_LDB(B1, 0, 1); PG_SCHED; PG_LDA(At, 0, 0); PG_STAGE_A(PG_SA(1, 1), a1, 1, false);
            PG_WAIT_V(8); PG_WAIT_L(0); PG_BAR; PG_MMA(0, 0, At, B0); PG_MMA(0, 1, At, B1); PG_BAR; PG_SCHED;
            PG_LDA(At, 0, 1); PG_STAGE(PG_SB(0, 0), b2, voffB); PG_STAGE(PG_SB(0, 1), b2 + hstepB, voffB); PG_STAGE_A(PG_SA(0, 0), a2, 0, nx_);
            PG_WAIT_V(8); PG_WAIT_L(0); PG_BAR; if (live1) { PG_MMA(1, 0, At, B0); PG_MMA(1, 1, At, B1); } PG_BAR; PG_SCHED;
            PG_LDB(B0, 1, 0); PG_LDB(B1, 1, 1); PG_SCHED; PG_LDA(At, 1, 0); PG_STAGE_A(PG_SA(0, 1), a2, 1, nx_);
            PG_WAIT_V(8); PG_WAIT_L(0); PG_BAR; PG_MMA(0, 0, At, B0); PG_MMA(0, 1, At, B1); PG_BAR; PG_SCHED;
            PG_LDA(At, 1, 1); PG_STAGE(PG_SB(1, 0), b3, voffB); PG_STAGE(PG_SB(1, 1), b3 + hstepB, voffB); PG_STAGE_A(PG_SA(1, 0), a3, 0, nx_);
            PG_WAIT_V(8); PG_WAIT_L(0); PG_BAR; if (live1) { PG_MMA(1, 0, At, B0); PG_MMA(1, 1, At, B1); } PG_BAR; PG_SCHED;
        }
        if (wr == 0) PG_BAR;
        E(acc, cur, wr, wc, fr, fq);
        if (!has_next) break;
#pragma unroll
        for (int a = 0; a < 2; ++a)
#pragma unroll
            for (int b = 0; b < 2; ++b)
#pragma unroll
                for (int m = 0; m < 4; ++m)
#pragma unroll
                    for (int n = 0; n < 2; ++n) acc[a][b][m][n] = (f32x4){0.f, 0.f, 0.f, 0.f};
        cur = nxt; cA = nA; cB = nB; ++ui;
        if constexpr (GATHER) { _Pragma("unroll") for (int h_ = 0; h_ < 2; ++h_) _Pragma("unroll") for (int i_ = 0; i_ < 2; ++i_) gcur[h_][i_] = gnxt[h_][i_]; }
        if (wr == 1) PG_BAR;
    }
    PG_WAIT_V(0);
    PG_BAR;
    asm volatile("s_waitcnt vmcnt(0) lgkmcnt(0)" ::: "memory"); __syncthreads();
#undef PG_SA
#undef PG_STAGE_A
#undef PG_GOFF
#undef PG_SB
#undef PG_STAGE
#undef PG_LDA
#undef PG_LDB
#undef PG_MMA
#undef PG_WAIT_V
#undef PG_WAIT_L
#undef PG_BAR
#undef PG_SCHED
}
}

__device__ __forceinline__ void rope4(f32x4& v, float pos, int i0) {
#pragma unroll
    for (int h = 0; h < 2; ++h) {
        const float inv = exp2f(-(float)(i0 + h) * 0.41524101186092029f);
        const float ang = pos * inv; const float c = __cosf(ang), s = __sinf(ang);
        const float t1 = v[2 * h], t2 = v[2 * h + 1];
        v[2 * h] = t1 * c - t2 * s; v[2 * h + 1] = t2 * c + t1 * s;
    }
}
struct EpiG1 {
    bf16_t* P; float* statq; float* statkv; const int* pos; const float* rstd;
    __device__ __forceinline__ void operator()(EPI_ARGS) const {
        const int row0 = u.pm * 256 + wr * 64 + fr, colt = u.pn * 256 + wc * 32 + 4 * fq;
        const bool rope_tile = (u.pn == 22) && (wc >= 2);
        const bool sq = (u.pn >= 16 && u.pn < 20), skv = (u.pn == 20 || u.pn == 21);
        float rsv[2][4];
#pragma unroll
        for (int ai = 0; ai < 2; ++ai)
#pragma unroll
            for (int m = 0; m < 4; ++m) rsv[ai][m] = rstd[row0 + ai * 128 + m * 16];
#pragma unroll
        for (int ai = 0; ai < 2; ++ai)
#pragma unroll
            for (int m = 0; m < 4; ++m) {
                const int row = row0 + ai * 128 + m * 16; bf16_t* rowp = P + (size_t)row * PWF + colt; float ss = 0.f;
                const float ps = rope_tile ? (float)pos[row] : 0.f;
#pragma unroll
                for (int bj = 0; bj < 2; ++bj)
#pragma unroll
                    for (int n = 0; n < 2; ++n) { f32x4 v = acc[ai][bj][m][n] * rsv[ai][m];
                        if (rope_tile && bj == 0) { const int i0 = ((wc - 2) * 32 + n * 16 + 4 * fq) >> 1; rope4(v, ps, i0); }
                        ss += (v[0] * v[0] + v[1] * v[1]) + (v[2] * v[2] + v[3] * v[3]);
                        u32x2 o; o.x = cvt_pk_bf16(v[0], v[1]); o.y = cvt_pk_bf16(v[2], v[3]); *(u32x2*)(rowp + bj * 128 + n * 16) = o; }
                if (sq || skv) { ss += __shfl_xor(ss, 16); ss += __shfl_xor(ss, 32);
                    if (fq == 0) { if (sq) st_wt(statq + (size_t)row * 16 + (u.pn - 16) * 4 + wc, ss); else st_wt(statkv + (size_t)row * 8 + (u.pn - 20) * 4 + wc, ss); } }
            }
    }
};
template <int NPART, int KDIM, int ROPE_TILE0  > struct EpiNormed {
    bf16_t* O; int ldo; const float* stat; const int* pos;
    __device__ __forceinline__ void operator()(EPI_ARGS) const {
        const int row0 = u.pm * 256 + wr * 64 + fr, colt = u.pn * 256 + wc * 32 + 4 * fq;
        const bool rope_tile = u.pn >= ROPE_TILE0;
#pragma unroll
        for (int ai = 0; ai < 2; ++ai)
#pragma unroll
            for (int m = 0; m < 4; ++m) {
                const int row = row0 + ai * 128 + m * 16; float s = 0.f;
#pragma unroll
                for (int i = 0; i < NPART / 4; ++i) { const f32x4 q = *(const f32x4*)(stat + (size_t)row * NPART + 4 * i); s += (q[0] + q[1]) + (q[2] + q[3]); }
                const float rstd = rsqrtf(s * (1.f / (float)KDIM) + 1e-6f);
                const float ps = rope_tile ? (float)pos[row] : 0.f;
                bf16_t* rowp = O + (size_t)row * ldo + colt;
#pragma unroll
                for (int bj = 0; bj < 2; ++bj)
#pragma unroll
                    for (int n = 0; n < 2; ++n) { f32x4 v = acc[ai][bj][m][n] * rstd;
                        if (rope_tile) { const int i0 = ((bj * 128 + wc * 32 + n * 16 + 4 * fq) & 63) >> 1; rope4(v, ps, i0); }
                        u32x2 o; o.x = cvt_pk_bf16(v[0], v[1]); o.y = cvt_pk_bf16(v[2], v[3]); *(u32x2*)(rowp + bj * 128 + n * 16) = o; }
            }
    }
};
struct EpiRes {
    const bf16_t* Xi; bf16_t* H; float* SS;
    __device__ __forceinline__ void operator()(EPI_ARGS) const {
        const int row0 = u.pm * 256 + wr * 64 + fr, colt = u.pn * 256 + wc * 32 + 4 * fq;
#pragma unroll
        for (int ai = 0; ai < 2; ++ai)
#pragma unroll
            for (int m = 0; m < 4; ++m) { const int row = row0 + ai * 128 + m * 16; const size_t off = (size_t)row * 4096 + colt; float ss = 0.f;
#pragma unroll
                for (int bj = 0; bj < 2; ++bj)
#pragma unroll
                    for (int n = 0; n < 2; ++n) { const u32x2 xr = *(const u32x2*)(Xi + off + bj * 128 + n * 16); const f32x4 o = (f32x4){bf_lo(xr.x), bf_hi(xr.x), bf_lo(xr.y), bf_hi(xr.y)} + acc[ai][bj][m][n];
                        ss += (o[0] * o[0] + o[1] * o[1]) + (o[2] * o[2] + o[3] * o[3]);
                        u32x2 w; w.x = cvt_pk_bf16(o[0], o[1]); w.y = cvt_pk_bf16(o[2], o[3]); *(u32x2*)(H + off + bj * 128 + n * 16) = w; }
                ss += __shfl_xor(ss, 16); ss += __shfl_xor(ss, 32);
                if (fq == 0) st_wt(SS + (size_t)row * 128 + u.pn * 4 + wc, ss); }
    }
};
struct EpiBf16 {
    bf16_t* O; int ldo;
    __device__ __forceinline__ void operator()(EPI_ARGS) const {
        const int row0 = u.pm * 256 + wr * 64 + fr, colt = u.pn * 256 + wc * 32 + 4 * fq;
#pragma unroll
        for (int ai = 0; ai < 2; ++ai)
#pragma unroll
            for (int m = 0; m < 4; ++m) { bf16_t* rowp = O + (size_t)(row0 + ai * 128 + m * 16) * ldo + colt;
#pragma unroll
                for (int bj = 0; bj < 2; ++bj)
#pragma unroll
                    for (int n = 0; n < 2; ++n) { const f32x4 v = acc[ai][bj][m][n]; u32x2 o; o.x = cvt_pk_bf16(v[0], v[1]); o.y = cvt_pk_bf16(v[2], v[3]); *(u32x2*)(rowp + bj * 128 + n * 16) = o; } }
    }
};
struct EpiBf16R {
    bf16_t* O; int ldo; const float* rstd;
    __device__ __forceinline__ void operator()(EPI_ARGS) const {
        const int row0 = u.pm * 256 + wr * 64 + fr, colt = u.pn * 256 + wc * 32 + 4 * fq;
        float rs[2][4];
#pragma unroll
        for (int ai = 0; ai < 2; ++ai)
#pragma unroll
            for (int m = 0; m < 4; ++m) rs[ai][m] = rstd[row0 + ai * 128 + m * 16];
#pragma unroll
        for (int ai = 0; ai < 2; ++ai)
#pragma unroll
            for (int m = 0; m < 4; ++m) { bf16_t* rowp = O + (size_t)(row0 + ai * 128 + m * 16) * ldo + colt;
#pragma unroll
                for (int bj = 0; bj < 2; ++bj)
#pragma unroll
                    for (int n = 0; n < 2; ++n) { const f32x4 v = acc[ai][bj][m][n] * rs[ai][m]; u32x2 o; o.x = cvt_pk_bf16(v[0], v[1]); o.y = cvt_pk_bf16(v[2], v[3]); *(u32x2*)(rowp + bj * 128 + n * 16) = o; } }
    }
};
struct EpiLogits {
    float* L;
    __device__ __forceinline__ void operator()(EPI_ARGS) const {
        if (wc >= 2) return;
        const int row0 = u.pm * 256 + wr * 64 + fr;
#pragma unroll
        for (int ai = 0; ai < 2; ++ai)
#pragma unroll
            for (int m = 0; m < 4; ++m)
#pragma unroll
                for (int n = 0; n < 2; ++n) *(f32x4*)(L + ((size_t)u.pn * T + (row0 + ai * 128 + m * 16)) * 64 + wc * 32 + n * 16 + 4 * fq) = acc[ai][0][m][n];
    }
};
struct EpiSilu {
    bf16_t* Act; const int* prow; const float* rstd; unsigned* tc;
    __device__ __forceinline__ void operator()(EPI_ARGS) const {
        const int row0 = u.pm * 256 + wr * 64 + fr, colt = u.pn * 128 + wc * 32 + 4 * fq;
#pragma unroll
        for (int ai = 0; ai < 2; ++ai)
#pragma unroll
            for (int m = 0; m < 4; ++m) { const int gr = row0 + ai * 128 + m * 16; const float rs = rstd[prow[gr] >> 1]; bf16_t* rowp = Act + (size_t)gr * 512 + colt;
#pragma unroll
                for (int n = 0; n < 2; ++n) { const f32x4 g = acc[ai][0][m][n] * rs, up = acc[ai][1][m][n] * rs; f32x4 h;
#pragma unroll
                    for (int j = 0; j < 4; ++j) h[j] = g[j] / (1.f + __expf(-g[j])) * up[j];
                    st_wt8(rowp + n * 16, cvt_pk_bf16(h[0], h[1]), cvt_pk_bf16(h[2], h[3])); } }
        asm volatile("s_waitcnt vmcnt(0)" ::: "memory");
        if (fr == 0 && fq == 0) (void)__hip_atomic_fetch_add(tc + u.pm * 32, 1u, __ATOMIC_RELAXED, __HIP_MEMORY_SCOPE_AGENT);
    }
};
struct EpiDown {
    bf16_t* Y; const int* prow; const float* wrow;
    __device__ __forceinline__ void operator()(EPI_ARGS) const {
        const int colt = u.pn * 256 + wc * 32 + 4 * fq;
#pragma unroll
        for (int ai = 0; ai < 2; ++ai)
#pragma unroll
            for (int m = 0; m < 4; ++m) { const int lr = ai * 128 + wr * 64 + m * 16 + fr;
                if (lr < u.rows) { const int gr = u.pm * 256 + lr; const int pair = prow[gr]; const float w = wrow[gr]; bf16_t* rowp = Y + (size_t)pair * 4096 + colt;
#pragma unroll
                    for (int bj = 0; bj < 2; ++bj)
#pragma unroll
                        for (int n = 0; n < 2; ++n) { const f32x4 v = acc[ai][bj][m][n] * w; u32x2 o; o.x = cvt_pk_bf16(v[0], v[1]); o.y = cvt_pk_bf16(v[2], v[3]); *(u32x2*)(rowp + bj * 128 + n * 16) = o; } } }
    }
};
struct EpiGlu {
    const bf16_t* Xi; bf16_t* H; float* SS;
    __device__ __forceinline__ void operator()(EPI_ARGS) const {
        const int row0 = u.pm * 256 + wr * 64 + fr, colt = u.pn * 128 + wc * 32 + 4 * fq;
#pragma unroll
        for (int ai = 0; ai < 2; ++ai)
#pragma unroll
            for (int m = 0; m < 4; ++m) { const int row = row0 + ai * 128 + m * 16; const size_t off = (size_t)row * 4096 + colt; float ss = 0.f;
#pragma unroll
                for (int n = 0; n < 2; ++n) { const f32x4 v = acc[ai][0][m][n], g = acc[ai][1][m][n]; const u32x2 xr = *(const u32x2*)(Xi + off + n * 16); f32x4 r = {bf_lo(xr.x), bf_hi(xr.x), bf_lo(xr.y), bf_hi(xr.y)};
#pragma unroll
                    for (int j = 0; j < 4; ++j) r[j] += v[j] / (1.f + __expf(-g[j]));
                    ss += (r[0] * r[0] + r[1] * r[1]) + (r[2] * r[2] + r[3] * r[3]);
                    u32x2 w; w.x = cvt_pk_bf16(r[0], r[1]); w.y = cvt_pk_bf16(r[2], r[3]); *(u32x2*)(H + off + n * 16) = w; }
                ss += __shfl_xor(ss, 16); ss += __shfl_xor(ss, 32);
                if (fq == 0) st_wt(SS + (size_t)row * 128 + u.pn * 4 + wc, ss); }
    }
};

__device__ __forceinline__ void indexer_unit(const bf16_t* __restrict__ P, unsigned* mask, int b, int qp, int lane) {
    const int n = lane & 31, hi = lane >> 5, q0 = 2 * qp;
    const size_t tok0 = (size_t)b * SEQ;
    const int aq = q0 + ((n >> 2) & 1), ah = (n & 3) + 4 * (n >> 3);
    const bf16_t* ap = P + (tok0 + aq) * PWF + FC_IQ + ah * 64 + 8 * hi;
    bf16x8 af[4];
#pragma unroll
    for (int ks = 0; ks < 4; ++ks) af[ks] = *(const bf16x8*)(ap + 16 * ks);
    float w[16];
    { const u32x4 w0 = *(const u32x4*)(P + (tok0 + q0 + hi) * PWF + FC_IW), w1 = *(const u32x4*)(P + (tok0 + q0 + hi) * PWF + FC_IW + 8);
      const float sc_ = 0.03125f;
#pragma unroll
      for (int i = 0; i < 4; ++i) { w[2 * i] = bf_lo(w0[i]) * sc_; w[2 * i + 1] = bf_hi(w0[i]) * sc_; w[8 + 2 * i] = bf_lo(w1[i]) * sc_; w[8 + 2 * i + 1] = bf_hi(w1[i]) * sc_; } }
    const int njt = (q0 + 1) / 32 + 1;
    const int myq = q0 + hi;
    unsigned sc[64];
    const bf16_t* kp = P + (tok0 + n) * PWF + FC_IK + 8 * hi;
    bf16x8 kb[3][4];
#define IDX_LD(jt_) do { const bf16_t* kq_ = kp + (size_t)(jt_) * 32 * PWF; _Pragma("unroll") for (int ks = 0; ks < 4; ++ks) kb[(jt_) % 3][ks] = *(const bf16x8*)(kq_ + 16 * ks); } while (0)
    IDX_LD(0);
    if (1 < njt) IDX_LD(1);
#pragma unroll
    for (int jt = 0; jt < 64; ++jt) {
        unsigned kv = 0u;
        if (jt < njt) {
            if (jt + 2 < 64 && jt + 2 < njt) IDX_LD(jt + 2);
            f32x16 acc = {};
#pragma unroll
            for (int ks = 0; ks < 4; ++ks) acc = __builtin_amdgcn_mfma_f32_32x32x16_bf16(af[ks], kb[jt % 3][ks], acc, 0, 0, 0);
            float s = 0.f;
#pragma unroll
            for (int r = 0; r < 16; ++r) s = fmaf(w[r], fmaxf(acc[r], 0.f), s);
            const unsigned uu = __float_as_uint(s); const unsigned ok = (uu & 0x80000000u) ? ~uu : (uu | 0x80000000u);
            kv = (jt * 32 + n <= myq) ? ok : 0u;
        }
        sc[jt] = kv;
    }
#undef IDX_LD
    const int L = myq + 1;
    unsigned prefix = 0u; bool fin = (L <= NSEL);
    for (int bit = 31; bit >= 0; --bit) {
        const unsigned cand = prefix | (1u << bit);
        int c = 0;
#pragma unroll
        for (int jt = 0; jt < 64; ++jt) c += (sc[jt] >= cand) ? 1 : 0;
#pragma unroll
        for (int o = 1; o < 32; o <<= 1) c += __shfl_xor(c, o);
        if (!fin) { if (c >= NSEL) prefix = cand; if (c == NSEL) fin = true; }
        if (__all(fin)) break;
    }
    if (L <= NSEL) prefix = 1u;
    unsigned mylo = 0u, myhi = 0u;
#pragma unroll
    for (int jt = 0; jt < 64; ++jt) {
        const unsigned long long m = __ballot(sc[jt] >= prefix);
        if (lane == jt) { mylo = (unsigned)m; myhi = (unsigned)(m >> 32); }
    }
    mask[(tok0 + q0) * 64 + lane] = mylo;
    mask[(tok0 + q0 + 1) * 64 + lane] = myhi;
}

namespace att {
constexpr int SHM_V = 16384;
__device__ __forceinline__ int v_st(int k, int c) { const int kk = (k & ~0xC) | ((k & 4) << 1) | ((k & 8) >> 1); return ((kk >> 3) * 4 + (c >> 5)) * 512 + ((kk & 7) * 32 + (c & 31)) * 2; }
__device__ __forceinline__ int v_rd_base(int lane) { return ((lane & 3) << 3) | (((lane >> 2) & 3) << 6) | (((lane >> 4) & 1) << 5) | (((lane >> 5) & 1) << 8); }
constexpr int v_rd_off(int d0, int ks, int half) { return d0 * 512 + ks * 4096 + half * 2048; }
__device__ __forceinline__ int crow(int r, int hi) { return (r & 3) + 8 * (r >> 2) + 4 * hi; }
#define ATT_SBAR() __builtin_amdgcn_sched_barrier(0)

template <int VB>
__device__ __forceinline__ void pv_tile(f32x16* o, int vb0, bf16x8 pa0, bf16x8 pa1, bf16x8 pa2, bf16x8 pa3) {
#define TRRD(dst, off) asm volatile("ds_read_b64_tr_b16 %0, %1 offset:%2" : "=&v"(dst) : "v"(vb0), "i"(off) : "memory")
#define PV_D0(d0) do { s16x4 l0, l1, l2, l3, h0, h1, h2, h3; constexpr int b_ = VB * SHM_V + v_rd_off(d0, 0, 0); \
        TRRD(l0, b_); TRRD(h0, b_ + 2048); TRRD(l1, b_ + 4096); TRRD(h1, b_ + 6144); TRRD(l2, b_ + 8192); TRRD(h2, b_ + 10240); TRRD(l3, b_ + 12288); TRRD(h3, b_ + 14336); \
        asm volatile("s_waitcnt lgkmcnt(0)" ::: "memory"); ATT_SBAR(); \
        o[d0] = __builtin_amdgcn_mfma_f32_32x32x16_bf16(pa0, (bf16x8){l0[0], l0[1], l0[2], l0[3], h0[0], h0[1], h0[2], h0[3]}, o[d0], 0, 0, 0); \
        o[d0] = __builtin_amdgcn_mfma_f32_32x32x16_bf16(pa1, (bf16x8){l1[0], l1[1], l1[2], l1[3], h1[0], h1[1], h1[2], h1[3]}, o[d0], 0, 0, 0); \
        o[d0] = __builtin_amdgcn_mfma_f32_32x32x16_bf16(pa2, (bf16x8){l2[0], l2[1], l2[2], l2[3], h2[0], h2[1], h2[2], h2[3]}, o[d0], 0, 0, 0); \
        o[d0] = __builtin_amdgcn_mfma_f32_32x32x16_bf16(pa3, (bf16x8){l3[0], l3[1], l3[2], l3[3], h3[0], h3[1], h3[2], h3[3]}, o[d0], 0, 0, 0); } while (0)
    PV_D0(0); PV_D0(1); PV_D0(2); PV_D0(3);
#undef PV_D0
#undef TRRD
}

template <int VB, int SUBT>
__device__ __forceinline__ void pv_half(f32x16* o, int vb0, bf16x8 pa0, bf16x8 pa1) {
#define TRRD(dst, off) asm volatile("ds_read_b64_tr_b16 %0, %1 offset:%2" : "=&v"(dst) : "v"(vb0), "i"(off) : "memory")
#define PV_H0(d0) do { s16x4 l0, l1, h0, h1; constexpr int b_ = VB * SHM_V + v_rd_off(d0, 2 * SUBT, 0); \
        TRRD(l0, b_); TRRD(h0, b_ + 2048); TRRD(l1, b_ + 4096); TRRD(h1, b_ + 6144); \
        asm volatile("s_waitcnt lgkmcnt(0)" ::: "memory"); ATT_SBAR(); \
        o[d0] = __builtin_amdgcn_mfma_f32_32x32x16_bf16(pa0, (bf16x8){l0[0], l0[1], l0[2], l0[3], h0[0], h0[1], h0[2], h0[3]}, o[d0], 0, 0, 0); \
        o[d0] = __builtin_amdgcn_mfma_f32_32x32x16_bf16(pa1, (bf16x8){l1[0], l1[1], l1[2], l1[3], h1[0], h1[1], h1[2], h1[3]}, o[d0], 0, 0, 0); } while (0)
    PV_H0(0); PV_H0(1); PV_H0(2); PV_H0(3);
#undef PV_H0
#undef TRRD
}

struct AttPtrs {
    const bf16_t* Qn; int ldq; const bf16_t* Qr; int ldqr;
    const bf16_t* Kn; int ldk; const bf16_t* Kr; int ldkr;
    const bf16_t* V; int ldv; bf16_t* O; int ldo; const unsigned* mask; float c2;
};

template <int DQK, bool BITMASK>
__device__ __forceinline__ void attn_qblock(LAS char* lds, const AttPtrs& A, const int qb) {
    constexpr int KROW = DQK * 2 + 16, KBUF = 64 * KROW, NKC = DQK / 8, KPT = NKC / 8;
    int tid = threadIdx.x; asm volatile("" : "+v"(tid));
    const int wid = __builtin_amdgcn_readfirstlane(tid >> 6), lane = tid & 63, r32 = lane & 31, hi = lane >> 5;
    LAS char* V_lds = lds; LAS char* K_lds = lds + 2 * SHM_V;
    LAS float* wsf = (LAS float*)(lds + 2 * SHM_V + 2 * KBUF) + wid * 64; LAS float* li_l = wsf; LAS float* al_l = wsf + 32;
    const int qlo = qb * 256 + wid * 32, qrow = qlo + r32;
    const float c2 = A.c2;
    bf16x8 qr[8];
#pragma unroll
    for (int d0 = 0; d0 < 8; ++d0) qr[d0] = *(const bf16x8*)(A.Qn + (size_t)qrow * A.ldq + d0 * 16 + hi * 8);
    LAS char* qx = lds + 2 * SHM_V + 2 * KBUF + 2048 + wid * 4608 + r32 * 144 + hi * 16;
    if constexpr (DQK == 192) {
#pragma unroll
        for (int d0 = 0; d0 < 4; ++d0) *(LAS bf16x8*)(qx + d0 * 32) = *(const bf16x8*)(A.Qr + (size_t)qrow * A.ldqr + d0 * 16 + hi * 8);
    }
    const int sr = tid >> 4, sc = (tid & 15) * 8, vst0 = v_st(sr, sc), vst1 = v_st(32 + sr, sc);
    const int vb0 = (int)(unsigned)(size_t)V_lds + v_rd_base(lane);
    const int ntiles = 4 * (qb + 1);
    float m_reg = -1e30f, l_reg = 0.f; f32x16 o[4];
#pragma unroll
    for (int d = 0; d < 4; ++d) o[d] = (f32x16){};
    bf16x8 stk[KPT], stv0, stv1;
#define ATT_LOADT(t, MW) do { const int key0_ = (t) * 64; \
        if constexpr (BITMASK) MW = *(const u32x2*)(A.mask + (size_t)qrow * 64 + 2 * (t));     \
        _Pragma("unroll") for (int i_ = 0; i_ < 2; ++i_) { const int id_ = tid + 512 * i_, row_ = id_ >> 4, c_ = id_ & 15; \
            stk[i_] = *(const bf16x8*)(A.Kn + (size_t)(key0_ + row_) * A.ldk + c_ * 8); } \
        if constexpr (DQK == 192) stk[KPT - 1] = *(const bf16x8*)(A.Kr + (size_t)(key0_ + (tid >> 3)) * A.ldkr + (tid & 7) * 8); \
        stv0 = *(const bf16x8*)(A.V + (size_t)(key0_ + sr) * A.ldv + sc); stv1 = *(const bf16x8*)(A.V + (size_t)(key0_ + 32 + sr) * A.ldv + sc); } while (0)
#define ATT_WRITET(buf) do { \
        _Pragma("unroll") for (int i_ = 0; i_ < 2; ++i_) { const int id_ = tid + 512 * i_, row_ = id_ >> 4, c_ = id_ & 15; \
            *(LAS bf16x8*)(K_lds + (buf) * KBUF + row_ * KROW + c_ * 16) = stk[i_]; } \
        if constexpr (DQK == 192) *(LAS bf16x8*)(K_lds + (buf) * KBUF + (tid >> 3) * KROW + 256 + (tid & 7) * 16) = stk[KPT - 1]; \
        *(LAS bf16x8*)(V_lds + (buf) * SHM_V + vst0) = stv0; *(LAS bf16x8*)(V_lds + (buf) * SHM_V + vst1) = stv1; } while (0)
#define ATT_SUB(t, BUF, SUBT) do { \
        f32x16 p0 = (f32x16){}; \
        const LAS char* kb_ = K_lds + (BUF) * KBUF + (SUBT) * 32 * KROW + r32 * KROW + hi * 16; \
        _Pragma("unroll") for (int d0 = 0; d0 < 8; ++d0) { const bf16x8 k0_ = *(const LAS bf16x8*)(kb_ + d0 * 32); \
            p0 = __builtin_amdgcn_mfma_f32_32x32x16_bf16(k0_, qr[d0], p0, 0, 0, 0); } \
        if constexpr (DQK == 192) { _Pragma("unroll") for (int d0 = 0; d0 < 4; ++d0) { const bf16x8 k0_ = *(const LAS bf16x8*)(kb_ + 256 + d0 * 32); const bf16x8 q_ = *(const LAS bf16x8*)(qx + d0 * 32); \
            p0 = __builtin_amdgcn_mfma_f32_32x32x16_bf16(k0_, q_, p0, 0, 0, 0); } } \
        const float NEG_ = -__builtin_inff(); \
        if constexpr (BITMASK) { const unsigned w0_ = ((SUBT) ? mw.y : mw.x) >> (4 * hi); \
            _Pragma("unroll") for (int r = 0; r < 16; ++r) { const int c_ = (r & 3) + 8 * (r >> 2); if (!((w0_ >> c_) & 1u)) p0[r] = NEG_; } } \
        else { if ((t) * 64 + (SUBT) * 32 + 31 > qlo) { const int dq_ = qrow - (t) * 64 - (SUBT) * 32 - 4 * hi; \
            _Pragma("unroll") for (int r = 0; r < 16; ++r) { const int c_ = (r & 3) + 8 * (r >> 2); if (c_ > dq_) p0[r] = NEG_; } } } \
        float pmax_ = p0[0]; \
        _Pragma("unroll") for (int r = 1; r < 16; ++r) pmax_ = fmaxf(pmax_, p0[r]); \
        { auto rr_ = __builtin_amdgcn_permlane32_swap(__float_as_uint(pmax_), __float_as_uint(pmax_), false, false); pmax_ = fmaxf(__uint_as_float(rr_[0]), __uint_as_float(rr_[1])); } \
        float mn_, alpha_; \
        if (__all((pmax_ - m_reg) * c2 <= 8.f)) { mn_ = m_reg; alpha_ = 1.f; } \
        else { mn_ = fmaxf(m_reg, pmax_); alpha_ = __builtin_amdgcn_exp2f((m_reg - mn_) * c2); m_reg = mn_; } \
        const float mnL_ = -mn_ * c2; \
        _Pragma("unroll") for (int r = 0; r < 16; ++r) p0[r] = __builtin_amdgcn_exp2f(fmaf(p0[r], c2, mnL_)); \
        float ps_ = 0.f; \
        _Pragma("unroll") for (int r = 0; r < 16; ++r) ps_ += p0[r]; \
        { auto rr_ = __builtin_amdgcn_permlane32_swap(__float_as_uint(ps_), __float_as_uint(ps_), false, false); ps_ = __uint_as_float(rr_[0]) + __uint_as_float(rr_[1]); } \
        l_reg = l_reg * alpha_ + ps_; \
        if (__any(alpha_ < 1.f)) { if (hi == 0) al_l[r32] = alpha_; asm volatile("s_waitcnt lgkmcnt(0)" ::: "memory"); \
            _Pragma("unroll") for (int d_ = 0; d_ < 4; ++d_) _Pragma("unroll") for (int r = 0; r < 16; ++r) o[d_][r] *= al_l[crow(r, hi)]; } \
        bf16x8 pa0, pa1; \
        ATT_PK4(p0, 0, pa0); ATT_PK4(p0, 8, pa1); \
        pv_half<BUF, SUBT>(o, vb0, pa0, pa1); } while (0)
#define ATT_COMPUTE(t, BUF, MW) do { if ((t) * 64 <= qlo + 31) { \
        const u32x2 mw = MW; \
        ATT_SUB(t, BUF, 0); \
        if ((t) * 64 + 32 <= qlo + 31) ATT_SUB(t, BUF, 1); } } while (0)
#define ATT_PK4(P, B_, OUT) do { const unsigned a0 = cvt_pk_bf16(P[B_ + 0], P[B_ + 1]), a1 = cvt_pk_bf16(P[B_ + 2], P[B_ + 3]); \
        const unsigned b0 = cvt_pk_bf16(P[B_ + 4], P[B_ + 5]), b1 = cvt_pk_bf16(P[B_ + 6], P[B_ + 7]); \
        auto r0 = __builtin_amdgcn_permlane32_swap(a0, b0, false, false); auto r1 = __builtin_amdgcn_permlane32_swap(a1, b1, false, false); \
        u32x4 w_ = {r0[0], r1[0], r0[1], r1[1]}; OUT = *reinterpret_cast<bf16x8*>(&w_); } while (0)
    u32x2 mwA = {0u, 0u}, mwB = {0u, 0u};
    ATT_LOADT(0, mwA); ATT_WRITET(0); __syncthreads();
    for (int t = 0; t < ntiles; t += 2) {
        ATT_LOADT(t + 1, mwB);
        ATT_COMPUTE(t, 0, mwA);
        ATT_WRITET(1);
        __syncthreads();
        if (t + 2 < ntiles) ATT_LOADT(t + 2, mwA);
        ATT_COMPUTE(t + 1, 1, mwB);
        if (t + 2 < ntiles) ATT_WRITET(0);
        __syncthreads();
    }
#undef ATT_LOADT
#undef ATT_WRITET
#undef ATT_COMPUTE
#undef ATT_PK4
    if (hi == 0) li_l[r32] = l_reg;
    asm volatile("s_waitcnt lgkmcnt(0)" ::: "memory");
    bf16_t* Ow = A.O + (size_t)qlo * A.ldo;
#pragma unroll
    for (int r = 0; r < 16; ++r) { const int orow = crow(r, hi); const float rl = __builtin_amdgcn_rcpf(li_l[orow]);
#pragma unroll
        for (int d0 = 0; d0 < 4; ++d0) { const float v = o[d0][r] * rl; const float vn = __shfl_xor(v, 1);
            if ((r32 & 1) == 0) *(unsigned*)(Ow + (size_t)orow * A.ldo + d0 * 32 + r32) = cvt_pk_bf16(v, vn); } }
    __syncthreads();
}
}

__device__ __forceinline__ void moe_route_wg(const float* LOG, const float* SS, int npart, float* RSTD, const float* bg, const float* be, int* EID, float* WT, unsigned* HIST, int bx, int tid) {
    if (tid >= 64) return;
    const int lane = tid; const bool valid = lane < 32; const int tok = bx * 32 + (lane & 31);
    const float* lr = LOG + (size_t)tok * 64;
    float ssum = 0.f;
    for (int i = 0; i < npart; i += 4) { const f32x4 q = *(const f32x4*)(SS + (size_t)tok * 128 + i); ssum += (q[0] + q[1]) + (q[2] + q[3]); }
    const float rs = rsqrtf(ssum * (1.f / 4096.f) + 1e-6f);
    if (valid) RSTD[tok] = rs;
    float g[4]; float mx = -__builtin_inff();
#pragma unroll
    for (int j = 0; j < 4; ++j) { float s = 0.f;
#pragma unroll
        for (int sp = 0; sp < 8; ++sp) s += lr[(size_t)sp * T * 64 + 32 + j];
        g[j] = s * rs + bg[j]; mx = fmaxf(mx, g[j]); }
    float sum = 0.f; int gs = 0; float gb = g[0];
#pragma unroll
    for (int j = 0; j < 4; ++j) { sum += __expf(g[j] - mx); if (g[j] > gb) { gb = g[j]; gs = j; } }
    const float ggate = __expf(gb - mx) / sum;
    float e[8];
#pragma unroll
    for (int j = 0; j < 8; ++j) { float s = 0.f;
#pragma unroll
        for (int sp = 0; sp < 8; ++sp) s += lr[(size_t)sp * T * 64 + gs * 8 + j];
        e[j] = s * rs + be[gs * 8 + j]; }
    int i0 = 0; float v0 = e[0];
#pragma unroll
    for (int j = 1; j < 8; ++j) if (e[j] > v0) { v0 = e[j]; i0 = j; }
    int i1 = 0; float v1 = -__builtin_inff();
#pragma unroll
    for (int j = 0; j < 8; ++j) if (j != i0 && e[j] > v1) { v1 = e[j]; i1 = j; }
    const float p0 = 1.f, p1 = __expf(v1 - v0);
    const int e0 = gs * 8 + i0, e1 = gs * 8 + i1;
    if (valid) { EID[tok * 2] = e0; EID[tok * 2 + 1] = e1; WT[tok * 2] = ggate * p0 / (p0 + p1); WT[tok * 2 + 1] = ggate * p1 / (p0 + p1); }
    unsigned mine = 0u;
#pragma unroll 4
    for (int ee = 0; ee < NE; ++ee) {
        const unsigned c = (unsigned)__popcll(__ballot(valid && e0 == ee)) + (unsigned)__popcll(__ballot(valid && e1 == ee));
        if (lane == ee) mine = c;
    }
    if (valid) HIST[bx * 32 + lane] = mine;
}

__device__ __forceinline__ void moe_place_wg(LAS unsigned char* tab, const unsigned* HIST, const int* EID, const float* WT, unsigned* CNT, int* PROW, float* WROW,
                                             int bx, int G, int tid) {
    LAS int* rb = (LAS int*)tab;
    LAS int* posl = (LAS int*)tab + 64;
    const int lane = tid & 63;
    LAS int* red = (LAS int*)tab + 128;
    { const int e = tid & 31, wq = tid >> 5; int tot = 0, bef = 0;
#pragma unroll 4
      for (int w = wq; w < G; w += 16) { const int v = (int)HIST[w * 32 + e]; tot += v; bef += (w < bx) ? v : 0; }
      red[(wq * 32 + e) * 2] = tot; red[(wq * 32 + e) * 2 + 1] = bef; }
    __syncthreads();
    if (tid < 64) {
        const int e = lane & 31;
        int tot = 0, bef = 0;
#pragma unroll
        for (int wq = 0; wq < 16; ++wq) { tot += red[(wq * 32 + e) * 2]; bef += red[(wq * 32 + e) * 2 + 1]; }
        const int pad = ((tot + 255) >> 8) << 8;
        int base = 0;
#pragma unroll 4
        for (int j = 0; j < 32; ++j) { const int pj = __shfl(pad, j); base += (j < e) ? pj : 0; }
        if (lane < 32) { rb[e] = base + bef; if (bx == 0) CNT[e] = (unsigned)tot; if (bx == e) { posl[0] = base + tot; posl[1] = base + pad; } }
    }
    __syncthreads();
    if (bx < 32) { const int z0 = posl[0], z1 = posl[1]; for (int r = z0 + tid; r < z1; r += 512) st_wt(PROW + r, 0); }
    __syncthreads();
    if (tid < 64) {
        const bool valid = lane < 32; const int tok = bx * 32 + (lane & 31);
        const int e0 = EID[tok * 2], e1 = EID[tok * 2 + 1];
        int r0 = 0, r1 = 0;
#pragma unroll 4
        for (int tt = 0; tt < 32; ++tt) { const int a0 = __shfl(e0, tt), a1 = __shfl(e1, tt);
            if (tt < lane) { r0 += (a0 == e0) + (a1 == e0); r1 += (a0 == e1) + (a1 == e1); } }
        if (valid) { const int pos0 = rb[e0] + r0, pos1 = rb[e1] + r1;
            posl[2 * lane] = pos0; posl[2 * lane + 1] = pos1;
            st_wt(PROW + pos0, tok * 2); st_wt(PROW + pos1, tok * 2 + 1); st_wt(WROW + pos0, WT[tok * 2]); st_wt(WROW + pos1, WT[tok * 2 + 1]); }
    }
    __syncthreads();
}
__device__ __forceinline__ void combine_row(const bf16_t* xi, const bf16_t* y0, const bf16_t* y1, bf16_t* xo, const float* g, bf16_t* hn, float* fout, float* rs_out, int lane) {
    f32x4 v[16]; float s = 0.f;
#pragma unroll
    for (int j = 0; j < 16; ++j) { const u32x2 x = ((const u32x2*)xi)[lane + 64 * j], a = __builtin_nontemporal_load((const u32x2*)y0 + lane + 64 * j), b = __builtin_nontemporal_load((const u32x2*)y1 + lane + 64 * j);
        v[j].x = bf_lo(x.x) + bf_lo(a.x) + bf_lo(b.x); v[j].y = bf_hi(x.x) + bf_hi(a.x) + bf_hi(b.x); v[j].z = bf_lo(x.y) + bf_lo(a.y) + bf_lo(b.y); v[j].w = bf_hi(x.y) + bf_hi(a.y) + bf_hi(b.y);
        s += (v[j].x * v[j].x + v[j].y * v[j].y) + (v[j].z * v[j].z + v[j].w * v[j].w); }
    const float rstd = rsqrtf(wave_sum(s) * (1.f / 4096.f) + 1e-6f);
    if (rs_out) { if (lane == 0) st_wt(rs_out, rstd); }
    if (!hn && !fout) {
#pragma unroll
        for (int j = 0; j < 16; ++j) { u32x2 w; w.x = cvt_pk_bf16(v[j].x, v[j].y); w.y = cvt_pk_bf16(v[j].z, v[j].w); ((u32x2*)xo)[lane + 64 * j] = w; }
        return;
    }
#pragma unroll
    for (int j = 0; j < 16; ++j) { const f32x4 gg = ((const f32x4*)g)[lane + 64 * j];
        if (xo) { u32x2 w; w.x = cvt_pk_bf16(v[j].x, v[j].y); w.y = cvt_pk_bf16(v[j].z, v[j].w); ((u32x2*)xo)[lane + 64 * j] = w; }
        const f32x4 o = {v[j].x * rstd * gg.x, v[j].y * rstd * gg.y, v[j].z * rstd * gg.z, v[j].w * rstd * gg.w};
        if (hn) { u32x2 w; w.x = cvt_pk_bf16(o.x, o.y); w.y = cvt_pk_bf16(o.z, o.w); ((u32x2*)hn)[lane + 64 * j] = w; }
        if (fout) ((f32x4*)fout)[lane + 64 * j] = o; }
}

struct S5In { const float* lre; const float* lim; const float* logdt; const float* bre; const float* bim; const float* cre; const float* cim; const float* dsk; };
__device__ __forceinline__ void cmul(float ar, float ai, float br, float bi, float& cr, float& ci) { cr = ar * br - ai * bi; ci = ar * bi + ai * br; }
template <bool OUT>
__device__ __forceinline__ void s5_unit(LAS char* sl  , const S5In& W, const bf16_t* U, float* ELOC, bf16_t* YG, int b, int g, int ch, int lane) {
    const int n = lane & 31, hi = lane >> 5;
    float a1r[2], a1i[2], a2r[2], a2i[2], a3r[2], a3i[2], a4r[2], a4i[2];
    bf16x8 bfr[4];
    const float dt = __expf(W.logdt[g]);
#pragma unroll
    for (int X = 0; X < 2; ++X) {
        const int p = n + 32 * X, gi = g * S5P + p;
        const float lr = W.lre[gi], li = W.lim[gi];
        const float mag = __expf(lr * dt), ang = li * dt;
        const float are = mag * __cosf(ang), aim = mag * __sinf(ang);
        const float den = lr * lr + li * li, nr = are - 1.f;
        const float fre = (nr * lr + aim * li) / den, fim = (aim * lr - nr * li) / den;
        a1r[X] = are; a1i[X] = aim; cmul(are, aim, are, aim, a2r[X], a2i[X]); cmul(a2r[X], a2i[X], are, aim, a3r[X], a3i[X]); cmul(a2r[X], a2i[X], a2r[X], a2i[X], a4r[X], a4i[X]);
        const f32x4 br0 = *(const f32x4*)(W.bre + (size_t)gi * S5C + 8 * hi), br1 = *(const f32x4*)(W.bre + (size_t)gi * S5C + 8 * hi + 4);
        const f32x4 bi0 = *(const f32x4*)(W.bim + (size_t)gi * S5C + 8 * hi), bi1 = *(const f32x4*)(W.bim + (size_t)gi * S5C + 8 * hi + 4);
        const f32x4 re0 = br0 * fre - bi0 * fim, re1 = br1 * fre - bi1 * fim, im0 = bi0 * fre + br0 * fim, im1 = bi1 * fre + br1 * fim;
        u32x4 wr_ = {cvt_pk_bf16(re0[0], re0[1]), cvt_pk_bf16(re0[2], re0[3]), cvt_pk_bf16(re1[0], re1[1]), cvt_pk_bf16(re1[2], re1[3])};
        u32x4 wi_ = {cvt_pk_bf16(im0[0], im0[1]), cvt_pk_bf16(im0[2], im0[3]), cvt_pk_bf16(im1[0], im1[1]), cvt_pk_bf16(im1[2], im1[3])};
        bfr[2 * X] = *reinterpret_cast<bf16x8*>(&wr_); bfr[2 * X + 1] = *reinterpret_cast<bf16x8*>(&wi_);
    }
    float cr[2] = {0.f, 0.f}, ci[2] = {0.f, 0.f};
    if (OUT && ch > 0) {
#pragma unroll
        for (int X = 0; X < 2; ++X) {
            float pr = a4r[X], pi = a4i[X];
#pragma unroll
            for (int s = 0; s < 6; ++s) { float tr, ti; cmul(pr, pi, pr, pi, tr, ti); pr = tr; pi = ti; }
            const float* el = ELOC + (((size_t)(b * S5G + g) * 8) * S5P + n + 32 * X) * 2;
            for (int j = 0; j < ch; ++j) { const f32x2 e = *(const f32x2*)(el + (size_t)j * S5P * 2); float tr, ti; cmul(pr, pi, cr[X], ci[X], tr, ti); cr[X] = tr + e.x; ci[X] = ti + e.y; }
        }
    }
    bf16x8 cf[4]; f32x4 dsk4 = {0.f, 0.f, 0.f, 0.f};
    const int c16 = lane & 15, q4 = lane >> 4;
    if (OUT) {
#pragma unroll
        for (int ks = 0; ks < 4; ++ks) { const size_t ci_ = ((size_t)g * S5C + c16) * S5P + 16 * ks + 4 * q4;
            const f32x4 xr = *(const f32x4*)(W.cre + ci_), xi = *(const f32x4*)(W.cim + ci_);
            u32x4 w_ = {cvt_pk_bf16(xr[0], -xi[0]), cvt_pk_bf16(xr[1], -xi[1]), cvt_pk_bf16(xr[2], -xi[2]), cvt_pk_bf16(xr[3], -xi[3])};
            cf[ks] = *reinterpret_cast<bf16x8*>(&w_); }
        dsk4 = *(const f32x4*)(W.dsk + g * S5C + 4 * q4);
    }
    const size_t tokc = (size_t)b * SEQ + (size_t)ch * 256;
    bf16x8 ua_n = *(const bf16x8*)(U + (tokc + n) * S5W + g * S5C + 8 * hi);
    u32x2 uu_n0 = {0u, 0u}, uu_n1 = {0u, 0u};
    if (OUT) { uu_n0 = *(const u32x2*)(U + (tokc + c16) * S5W + g * S5C + 4 * q4); uu_n1 = *(const u32x2*)(U + (tokc + 16 + c16) * S5W + g * S5C + 4 * q4); }
#pragma unroll 1
    for (int tl = 0; tl < 8; ++tl) {
        const size_t tok0 = tokc + tl * 32;
        const bf16x8 ua = ua_n; const u32x2 uu_c0 = uu_n0, uu_c1 = uu_n1;
        if (tl + 1 < 8) { const size_t tk1 = tok0 + 32;
            ua_n = *(const bf16x8*)(U + (tk1 + n) * S5W + g * S5C + 8 * hi);
            if (OUT) { uu_n0 = *(const u32x2*)(U + (tk1 + c16) * S5W + g * S5C + 4 * q4); uu_n1 = *(const u32x2*)(U + (tk1 + 16 + c16) * S5W + g * S5C + 4 * q4); } }
        f32x16 acc[4];
#pragma unroll
        for (int k = 0; k < 4; ++k) acc[k] = __builtin_amdgcn_mfma_f32_32x32x16_bf16(ua, bfr[k], (f32x16){}, 0, 0, 0);
#pragma unroll
        for (int X = 0; X < 2; ++X) {
            f32x16& R = acc[2 * X]; f32x16& I = acc[2 * X + 1];
            const float ar = a1r[X], ai = a1i[X];
            float er[4], ei[4];
#pragma unroll
            for (int gq = 0; gq < 4; ++gq) {
#pragma unroll
                for (int k = 1; k < 4; ++k) { const int r = 4 * gq + k; const float pr = R[r - 1], pi = I[r - 1]; R[r] += ar * pr - ai * pi; I[r] += ar * pi + ai * pr; }
                er[gq] = R[4 * gq + 3]; ei[gq] = I[4 * gq + 3];
            }
            float mr[4], mi[4]; float c_r = cr[X], c_i = ci[X];
#pragma unroll
            for (int gq = 0; gq < 4; ++gq) {
                const float or_ = __shfl_xor(er[gq], 32), oi_ = __shfl_xor(ei[gq], 32);
                const float e0r = hi ? or_ : er[gq], e0i = hi ? oi_ : ei[gq];
                const float e1r = hi ? er[gq] : or_, e1i = hi ? ei[gq] : oi_;
                const float c0r = c_r, c0i = c_i; float tr, ti;
                cmul(a4r[X], a4i[X], c_r, c_i, tr, ti); c_r = tr + e0r; c_i = ti + e0i;
                const float c1r = c_r, c1i = c_i;
                cmul(a4r[X], a4i[X], c_r, c_i, tr, ti); c_r = tr + e1r; c_i = ti + e1i;
                mr[gq] = hi ? c1r : c0r; mi[gq] = hi ? c1i : c0i;
            }
            cr[X] = c_r; ci[X] = c_i;
            if (OUT) {
#pragma unroll
                for (int gq = 0; gq < 4; ++gq) {
                    float tr, ti;
                    cmul(a1r[X], a1i[X], mr[gq], mi[gq], tr, ti); R[4 * gq + 0] += tr; I[4 * gq + 0] += ti;
                    cmul(a2r[X], a2i[X], mr[gq], mi[gq], tr, ti); R[4 * gq + 1] += tr; I[4 * gq + 1] += ti;
                    cmul(a3r[X], a3i[X], mr[gq], mi[gq], tr, ti); R[4 * gq + 2] += tr; I[4 * gq + 2] += ti;
                    cmul(a4r[X], a4i[X], mr[gq], mi[gq], tr, ti); R[4 * gq + 3] += tr; I[4 * gq + 3] += ti;
                }
#pragma unroll
                for (int r = 0; r < 16; ++r) { const int row = (r & 3) + 8 * (r >> 2) + 4 * hi;
                    *(LAS unsigned*)(sl + row * 272 + X * 128 + n * 4) = cvt_pk_bf16(R[r], I[r]); }
            }
        }
        if (OUT) {
            asm volatile("s_waitcnt lgkmcnt(0)" ::: "memory");
#pragma unroll
            for (int hf = 0; hf < 2; ++hf) {
                f32x4 y = {0.f, 0.f, 0.f, 0.f};
#pragma unroll
                for (int ks = 0; ks < 4; ++ks) { const bf16x8 sf = *(const LAS bf16x8*)(sl + (16 * hf + c16) * 272 + (32 * ks + 8 * q4) * 2);
                    y = __builtin_amdgcn_mfma_f32_16x16x32_bf16(cf[ks], sf, y, 0, 0, 0); }
                const size_t tk = tok0 + 16 * hf + c16;
                const u32x2 uu = hf ? uu_c1 : uu_c0;
                y[0] += dsk4[0] * bf_lo(uu.x); y[1] += dsk4[1] * bf_hi(uu.x); y[2] += dsk4[2] * bf_lo(uu.y); y[3] += dsk4[3] * bf_hi(uu.y);
#pragma unroll
                for (int i = 0; i < 4; ++i) { const float z = 0.7978845608028654f * (y[i] + 0.044715f * y[i] * y[i] * y[i]); const float th = 1.f - 2.f / (1.f + __expf(2.f * z)); y[i] = 0.5f * y[i] * (1.f + th); }
                st_wt8(YG + tk * S5W + g * S5C + 4 * q4, cvt_pk_bf16(y[0], y[1]), cvt_pk_bf16(y[2], y[3]));
            }
            asm volatile("s_waitcnt lgkmcnt(0)" ::: "memory");
        }
    }
    if (!OUT && hi == 0) {
#pragma unroll
        for (int X = 0; X < 2; ++X) { f32x2 e = {cr[X], ci[X]}; *(f32x2*)(ELOC + (((size_t)(b * S5G + g) * 8 + ch) * S5P + n + 32 * X) * 2) = e; }
    }
}

struct MKArgs { const float* in[27]; float* out; unsigned char* ws; int ph_lo, ph_hi; };
constexpr int NPHASE = 21;

__global__ void __launch_bounds__(512, 2) mk_fwd(MKArgs args) {
    extern __shared__ __attribute__((aligned(16))) unsigned char lds_raw[];
    LAS unsigned char* lds = (LAS unsigned char*)lds_raw;
    const int tid = threadIdx.x, lane = tid & 63, wave = __builtin_amdgcn_readfirstlane(tid >> 6);
    const int G = gridDim.x, bx = blockIdx.x;
    const int gw = bx * 8 + wave, NGW = G * 8;
    volatile LAS unsigned* MISC = (volatile LAS unsigned*)(lds + MISC_OFF);
    if (tid < 32) MISC[tid] = 0u;
    __syncthreads();
    unsigned char* ws = args.ws;
    const int lo = args.ph_lo, hi = args.ph_hi;
    XcdBarrier bar; bar.bar = (unsigned*)(ws + F_CTL) + CW_BAR; bar.x = 0; bar.st = MISC + 8;
    if (hi - lo > 1) bar = xcd_barrier_post((unsigned*)(ws + F_CTL) + CW_BAR, MISC + 8);
#ifndef PHMASK
#define PHMASK 0xffffffffu
#endif
#define IN(k) (((PHMASK >> (k)) & 1u) && lo <= (k) && (k) < hi)
#define SEAM(k) do { if (IN(k) && IN((k) + 1)) xcd_barrier(bar); } while (0)
    constexpr size_t HNS = (size_t)T * 4096;
#define x_in ((const float*)args.in[0])
#define positions ((const int*)args.in[1])
#define norm_mix ((const float*)args.in[2])
#define norm_ffn ((const float*)args.in[3])
#define norm_final ((const float*)args.in[4])
#define BT1 ((bf16_t*)(ws + F_BT1))
#define BT2A ((bf16_t*)(ws + F_BT2A))
#define BT2B ((bf16_t*)(ws + F_BT2B))
#define BT3 ((bf16_t*)(ws + F_BT3))
#define BT4 ((bf16_t*)(ws + F_BT4))
#define BT5 ((bf16_t*)(ws + F_BT5))
#define BTR ((bf16_t*)(ws + F_BTR))
#define BTGU ((bf16_t*)(ws + F_BTGU))
#define BTDN ((bf16_t*)(ws + F_BTDN))
#define HN ((bf16_t*)(ws + F_HN))
#define P ((bf16_t*)(ws + F_P))
#define STQ ((float*)(ws + F_STQ))
#define STKV ((float*)(ws + F_STKV))
#define MASK ((unsigned*)(ws + F_MASK))
#define Q ((bf16_t*)(ws + F_Q))
#define KV ((bf16_t*)(ws + F_KV))
#define CC ((bf16_t*)(ws + F_CC))
#define XBH ((bf16_t*)(ws + F_XB))
#define LOG ((float*)(ws + F_LOG))
#define EID ((int*)(ws + F_EID))
#define WT ((float*)(ws + F_WT))
#define HIST ((unsigned*)(ws + F_HIST))
#define CNT ((unsigned*)(ws + F_CNT))
#define PROW ((int*)(ws + F_PROW))
#define WROW ((float*)(ws + F_WROW))
#define ACT ((bf16_t*)(ws + F_ACT))
#define Y ((bf16_t*)(ws + F_Y))
#define SS ((float*)(ws + F_SS))
#define RSTD ((float*)(ws + F_RSTD))
#define U ((bf16_t*)(ws + F_U))
#define YG ((bf16_t*)(ws + F_YG))
#define ELOC ((float*)(ws + F_ELOC))

#define MOE_CONV(L, I0, I1) MOE_CONV_X(L, I0, I1, gw, NGW)
#define MOE_CONV_X(L, I0, I1, GW_, NGW_) do { for (int id_ = (I0) + (GW_); id_ < (I1); id_ += 4 * (NGW_)) moe_conv4(args.in[25], args.in[26], BTGU, BTDN, norm_ffn + (L) * 4096, (L), id_, (NGW_), (I1), lane); } while (0)
    if (IN(0)) {
        tr_matrix(args.in[5], 4096, PW, BT1, norm_mix, gw, NGW, lane, MapG1{});
        for (int i = gw * 64 + lane; i < (PWF - PW) * 4096 / 8; i += NGW * 64) ((u32x4*)(BT1 + (size_t)PW * 4096))[i] = (u32x4){0u, 0u, 0u, 0u};
        tr_matrix(args.in[8], 1024, 3072, BT2A, args.in[6], gw, NGW, lane, MapUQ{});
        tr_matrix(args.in[9], 512, 4096, BT2B, args.in[7], gw, NGW, lane, MapUKV{});
        tr_matrix(args.in[10], 4096, 4096, BT3, nullptr, gw, NGW, lane, MapId{});
        tr_matrix(args.in[11], 4096, 2048, BT4, norm_mix + 4096, gw, NGW, lane, MapId{});
        tr_matrix(args.in[20], 2048, 8192, BT5, nullptr, gw, NGW, lane, MapPair{4096});
        for (int l = 0; l < 2; ++l) {
            bf16_t* br = BTR + (size_t)l * 256 * 4096;
            for (int i = gw * 64 + lane; i < (256 - 36) * 4096 / 8; i += NGW * 64) ((u32x4*)(br + (size_t)36 * 4096))[i] = (u32x4){0u, 0u, 0u, 0u};
            tr_matrix(args.in[23] + (size_t)l * 4096 * 32, 4096, 32, br, norm_ffn + l * 4096, gw, NGW, lane, MapId{});
            tr_matrix(args.in[21] + (size_t)l * 4096 * 4, 4096, 4, br, norm_ffn + l * 4096, gw, NGW, lane, MapOff{32});
        }
        for (int m = gw; m < T; m += NGW) cast_row_bf16(x_in + (size_t)m * 4096, HN + (size_t)m * 4096, (float*)(ws + F_RS1) + m, lane);
    }
    SEAM(0);
    if (IN(1)) {
        pg::PlainSched S; S.init(HN, 4096 * 2, BT1, 4096, T, PWF, G, bx);
        EpiG1 E{P, STQ, STKV, positions, (const float*)(ws + F_RS1)};
        pg::gemm_phase(lds, 4096, (size_t)4096 * 2, S, E);
        if (G == 256) { if (bx >= 224) MOE_CONV_X(0, 0, 8192, (bx - 224) * 8 + wave, 256); } else MOE_CONV(0, 0, 8192);
    }
    SEAM(1);
    if (IN(2)) {
        { pg::PlainSched S; S.init(P + FC_CQ, PWF * 2, BT2A, 1024, T, 3072, G, bx);
          EpiNormed<16, 1024, 8> E{Q, 3072, STQ, positions};
          pg::gemm_phase(lds, 1024, (size_t)PWF * 2, S, E); }
        { pg::PlainSched S; S.init(P + FC_CKV, PWF * 2, BT2B, 512, T, 4096, G, bx);
          if (G == 256) { if (bx < 128) S.deal(bx, 256, 1); else S.deal(bx, 128, 3); }
          EpiNormed<8, 512, 1000> E{KV, 4096, STKV, positions};
          pg::gemm_phase(lds, 512, (size_t)PWF * 2, S, E); }
        if (wave & 1) MOE_CONV(0, 8192, 32768);
        for (int u = gw; u < 2048; u += NGW) {
            indexer_unit(P, MASK, u >> 10, u & 1023, lane);
            const int u2 = 4095 - u; indexer_unit(P, MASK, u2 >> 10, u2 & 1023, lane);
        }
        if (!(wave & 1)) MOE_CONV(0, 8192, 32768);
    }
    SEAM(2);
    if (IN(3)) {
        for (int it = bx; it < 256; it += G) {
            const int bh = it >> 2, b = bh >> 4, h = bh & 15, xq = it & 3;
            const size_t t0 = (size_t)b * SEQ;
            att::AttPtrs A;
            A.Qn = P + t0 * PWF + FC_QA + h * 128; A.ldq = PWF; A.Qr = nullptr; A.ldqr = 0;
            A.Kn = P + t0 * PWF + FC_KA + (h >> 2) * 128; A.ldk = PWF; A.Kr = nullptr; A.ldkr = 0;
            A.V = P + t0 * PWF + FC_VA + (h >> 2) * 128; A.ldv = PWF; A.O = CC + t0 * 4096 + h * 128; A.ldo = 4096;
            A.mask = MASK + t0 * 64; A.c2 = 0.12751743f;
            if ((bx & 3) == 0) MOE_CONV(0, 32768, 98304);
            att::attn_qblock<128, true>((LAS char*)lds, A, xq);
            if ((bx & 3) == 1) MOE_CONV(0, 32768, 98304);
            att::attn_qblock<128, true>((LAS char*)lds, A, 7 - xq);
        }
        for (int it = bx; it < 256; it += G) {
            const int bh = it >> 2, b = bh >> 4, h = bh & 15, xq = it & 3;
            const size_t t0 = (size_t)b * SEQ;
            att::AttPtrs A;
            A.Qn = Q + t0 * 3072 + h * 128; A.ldq = 3072; A.Qr = Q + t0 * 3072 + 2048 + h * 64; A.ldqr = 3072;
            A.Kn = KV + t0 * 4096 + h * 128; A.ldk = 4096; A.Kr = P + t0 * PWF + FC_KR; A.ldkr = PWF;
            A.V = KV + t0 * 4096 + 2048 + h * 128; A.ldv = 4096; A.O = CC + t0 * 4096 + 2048 + h * 128; A.ldo = 4096;
            A.mask = nullptr; A.c2 = 0.10411707f;
            if ((bx & 3) == 2) MOE_CONV(0, 32768, 98304);
            att::attn_qblock<192, false>((LAS char*)lds, A, xq);
            if ((bx & 3) == 3) MOE_CONV(0, 32768, 98304);
            att::attn_qblock<192, false>((LAS char*)lds, A, 7 - xq);
        }
    }
    SEAM(3);
    if (IN(4)) {
        pg::PlainSched S; S.init(CC, 4096 * 2, BT3, 4096, T, 4096, G, bx);
        EpiRes E{HN, HN + 1 * HNS, SS};
        pg::gemm_phase(lds, 4096, (size_t)4096 * 2, S, E);
    }
    SEAM(4);

#define EARLYQ 4
#define MOE_EARLY(totg, u1dn) int ni_ = ((totg) > G && (totg) < 2 * G) ? 2 * G - (totg) : 0; if (ni_ < 32) ni_ = 0; int ne_ = ni_ * EARLYQ; if (ne_ > (u1dn) || ne_ > 4 * G) { ni_ = 0; ne_ = 0; }
#define MOE_BLOCK(PB, L, NPART, XIN, XOUT, GNEXT, FINAL) do { \
    bf16_t* const HNL = HN + 1 * HNS; float* const LOGL = LOG + (size_t)(L) * 8 * T * 64; float* const SSL = SS + (size_t)(L) * T * 128; float* const RSTDL = RSTD + (size_t)(L) * T; \
    int* const EIDL = EID + (size_t)(L) * NPAIR; float* const WTL = WT + (size_t)(L) * NPAIR; unsigned* const HISTL = HIST + (L) * 256 * 32; unsigned* const CNTL = CNT + (L) * 1024; \
    int* const PROWL = PROW + (size_t)(L) * MAXROWS; float* const WROWL = WROW + (size_t)(L) * MAXROWS; bf16_t* const ACTL = ACT + (size_t)(L) * MAXROWS * 512; bf16_t* const YL = Y; unsigned* const TCL = (unsigned*)(ws + F_CTL + 65536) + (L) * 4096;     \
    if (IN((PB) + 0)) { pg::RouterSched S; S.A = (const char*)HNL; S.B = (const char*)(BTR + (size_t)(L) * 256 * 4096); S.G = G; S.c = bx; EpiLogits E{LOGL}; pg::gemm_phase(lds, 512, (size_t)4096 * 2, S, E, (size_t)4096 * 2); } \
    SEAM((PB) + 0); \
    if (IN((PB) + 1)) { moe_route_wg(LOGL, SSL, (NPART), RSTDL, args.in[22] + (L) * 4, args.in[24] + (L) * 32, EIDL, WTL, HISTL, bx, tid); } \
    SEAM((PB) + 1); \
    if (IN((PB) + 2)) { moe_place_wg(lds + TAB_OFF, HISTL, EIDL, WTL, CNTL, PROWL, WROWL, bx, G, tid); } \
    SEAM((PB) + 2); \
    if (IN((PB) + 3)) { pg::MoeSched S; S.A = (const char*)HNL; S.B = (const char*)(BTGU + (size_t)(L) * 32 * 1024 * 4096); S.cnt = CNTL; S.ldaB = 8192; S.tstepB = (size_t)256 * 4096 * 2; S.bexp = (size_t)1024 * 4096 * 2; S.NT = 4; S.ntsh = 2; S.G = G; S.c = bx; S.gather = 1; S.first = bx; S.step = G; S.lim = 1 << 30; S.load_counts(lds); \
        EpiSilu E{ACTL, PROWL, RSTDL, TCL}; pg::gemm_phase<EpiSilu, pg::MoeSched, true, true>(lds, 4096, (size_t)8192, S, E, 0, PROWL); \
          \
        { const int totg_ = S.total(), u1d_ = 4 * S.u1(); MOE_EARLY(totg_, u1d_); \
          if (ni_ > 0 && bx >= G - ni_) { \
            __syncthreads(); \
            pg::MoeSched S2; S2.A = (const char*)ACTL; S2.B = (const char*)(BTDN + (size_t)(L) * 32 * 4096 * 512); S2.cnt = CNTL; S2.ldaB = 1024; S2.tstepB = (size_t)256 * 512 * 2; S2.bexp = (size_t)4096 * 512 * 2; S2.NT = 16; S2.ntsh = 4; S2.G = G; S2.c = bx; S2.gather = 0; \
            S2.first = bx - (G - ni_); S2.step = ni_; S2.lim = EARLYQ; S2.load_counts(lds); \
            for (int k_ = 0; k_ < EARLYQ; ++k_) { pg::GUnit uu_; const bool ok_ = S2.next(k_, uu_); \
                if (ok_ && tid == 0) { unsigned sp_ = 0; while (xb_ld(TCL + uu_.pm * 32) < 32u) { __builtin_amdgcn_s_sleep(1); if ((++sp_ & 255u) == 0u && (xb_ld(&bar.bar[XB_TMO]) || sp_ > XB_SPIN_CAP)) break; } } } \
            if (tid == 0) { __builtin_amdgcn_fence(__ATOMIC_ACQUIRE, "agent"); asm volatile("s_waitcnt vmcnt(0)" ::: "memory"); } \
            __syncthreads(); \
            EpiDown E2{YL, PROWL, WROWL}; pg::gemm_phase<EpiDown, pg::MoeSched, false, true>(lds, 512, (size_t)1024, S2, E2); } } } \
    SEAM((PB) + 3); \
    if (IN((PB) + 4)) { pg::MoeSched S; S.A = (const char*)ACTL; S.B = (const char*)(BTDN + (size_t)(L) * 32 * 4096 * 512); S.cnt = CNTL; S.ldaB = 1024; S.tstepB = (size_t)256 * 512 * 2; S.bexp = (size_t)4096 * 512 * 2; S.NT = 16; S.ntsh = 4; S.G = G; S.c = bx; S.gather = 0; S.first = bx; S.step = G; S.lim = 1 << 30; S.load_counts(lds); \
        { const int totg_ = S.total() >> 2, u1d_ = S.u1(); MOE_EARLY(totg_, u1d_); S.first = ne_ + bx; }     \
        EpiDown E{YL, PROWL, WROWL}; pg::gemm_phase<EpiDown, pg::MoeSched, false, true>(lds, 512, (size_t)1024, S, E); } \
    SEAM((PB) + 4); \
    if (IN((PB) + 5)) { for (int m = gw; m < T; m += NGW) combine_row((XIN) + (size_t)m * 4096, YL + (size_t)(2 * m) * 4096, YL + (size_t)(2 * m + 1) * 4096, (FINAL) ? nullptr : (XOUT) + (size_t)m * 4096, (GNEXT), \
                                                                    nullptr, (FINAL) ? args.out + (size_t)m * 4096 : nullptr, (FINAL) ? nullptr : (float*)(ws + F_RS4) + m, lane); } \
    SEAM((PB) + 5); } while (0)

    MOE_BLOCK(5, 0, 64, HN + 1 * HNS, XBH, norm_mix + 4096, false);
    if (IN(11)) { pg::PlainSched S; S.init(XBH, 4096 * 2, BT4, 4096, T, 2048, G, bx); EpiBf16R E{U, 2048, (const float*)(ws + F_RS4)}; pg::gemm_phase(lds, 4096, (size_t)4096 * 2, S, E); }
    SEAM(11);
    { S5In W{args.in[12], args.in[13], args.in[14], args.in[15], args.in[16], args.in[17], args.in[18], args.in[19]};
      if (IN(12)) { if (wave & 1) MOE_CONV(1, 0, 32768);
        for (int u = gw; u < 4096; u += NGW) { const int ch = u & 7; if (ch < 7) s5_unit<false>((LAS char*)lds + wave * 8704, W, U, ELOC, YG, u >> 10, (u >> 3) & 127, ch, lane); }
        if (!(wave & 1)) MOE_CONV(1, 0, 32768); }
      SEAM(12);
      if (IN(13)) { if (wave & 1) MOE_CONV(1, 32768, 98304);
        for (int u = gw; u < 4096; u += NGW) s5_unit<true>((LAS char*)lds + wave * 8704, W, U, ELOC, YG, u >> 10, (u >> 3) & 127, u & 7, lane);
        if (!(wave & 1)) MOE_CONV(1, 32768, 98304); }
      SEAM(13); }
    if (IN(14)) { pg::PlainSched S; S.init(YG, 2048 * 2, BT5, 2048, T, 8192, G, bx); EpiGlu E{XBH, HN + 1 * HNS, SS + (size_t)T * 128}; pg::gemm_phase(lds, 2048, (size_t)2048 * 2, S, E); }
    SEAM(14);
    MOE_BLOCK(15, 1, 128, HN + 1 * HNS, XBH, norm_final, true);
#undef MOE_BLOCK
#undef MOE_CONV
#undef x_in
#undef positions
#undef norm_mix
#undef norm_ffn
#undef norm_final
#undef BT1
#undef BT2A
#undef BT2B
#undef BT3
#undef BT4
#undef BT5
#undef BTR
#undef BTGU
#undef BTDN
#undef HN
#undef P
#undef STQ
#undef STKV
#undef MASK
#undef Q
#undef KV
#undef CC
#undef XBH
#undef LOG
#undef EID
#undef WT
#undef HIST
#undef CNT
#undef PROW
#undef WROW
#undef ACT
#undef Y
#undef SS
#undef RSTD
#undef U
#undef YG
#undef ELOC
#undef IN
#undef SEAM
}

#if MODE == 1
struct ViewP { const void* fast; float* orc; double* part; long ldf, ldo; int rows, cols, map, fbf16, inject, fcol0, pad; };
__device__ __forceinline__ int view_map(int map, int c) {
    switch (map) {
        case 1: return MapG1{}(c);
        case 2: return (c < 32) ? 2 * c : 2 * (c - 32) + 1;
        case 3: return MapUQ{}(c);
        case 4: return MapUKV{}(c);
        default: return c;
    }
}
__global__ __launch_bounds__(256) void k_view(ViewP v) {
    __shared__ double shn[256], shd[256];
    double num = 0.0, den = 0.0;
    const long total = (long)v.rows * v.cols;
    for (long i = (long)blockIdx.x * 256 + threadIdx.x; i < total; i += (long)gridDim.x * 256) {
        const long r = i / v.cols; const int c = (int)(i % v.cols);
        const long fo = r * v.ldf + v.fcol0 + view_map(v.map, c);
        const float o = v.orc[r * v.ldo + c];
        if (v.inject) { if (v.fbf16) ((bf16_t*)v.fast)[fo] = (bf16_t)(cvt_pk_bf16(o, 0.f) & 0xffffu); else ((float*)v.fast)[fo] = o; }
        else { const float f = v.fbf16 ? __uint_as_float(((unsigned)((const bf16_t*)v.fast)[fo]) << 16) : ((const float*)v.fast)[fo];
            const double d = (double)f - (double)o; num += d * d; den += (double)o * (double)o; if (!(f == f)) num += 1e30; }
    }
    if (!v.inject) {
        shn[threadIdx.x] = num; shd[threadIdx.x] = den; __syncthreads();
        for (int s = 128; s > 0; s >>= 1) { if (threadIdx.x < s) { shn[threadIdx.x] += shn[threadIdx.x + s]; shd[threadIdx.x] += shd[threadIdx.x + s]; } __syncthreads(); }
        if (threadIdx.x == 0) { v.part[blockIdx.x * 2] = shn[0]; v.part[blockIdx.x * 2 + 1] = shd[0]; }
    }
}
__global__ __launch_bounds__(256) void k_view_mask(unsigned* mask, const unsigned char* sel, double* part, int inject) {
    __shared__ double shn[256], shd[256];
    double num = 0.0, den = 0.0;
    const long total = (long)T * 64;
    for (long i = (long)blockIdx.x * 256 + threadIdx.x; i < total; i += (long)gridDim.x * 256) {
        const long row = i >> 6; const int wd = (int)(i & 63);
        unsigned m = 0u;
        for (int bit = 0; bit < 32; ++bit) m |= (sel[row * SEQ + wd * 32 + bit] ? 1u : 0u) << bit;
        if (inject) mask[i] = m; else { num += (double)__popc(m ^ mask[i]); den += (double)__popc(m); }
    }
    if (!inject) {
        shn[threadIdx.x] = num; shd[threadIdx.x] = den; __syncthreads();
        for (int s = 128; s > 0; s >>= 1) { if (threadIdx.x < s) { shn[threadIdx.x] += shn[threadIdx.x + s]; shd[threadIdx.x] += shd[threadIdx.x + s]; } __syncthreads(); }
        if (threadIdx.x == 0) { part[blockIdx.x * 2] = shn[0]; part[blockIdx.x * 2 + 1] = shd[0]; }
    }
}
constexpr int VIEW_BLOCKS = 1024, MAX_SEAMS = 32;
__device__ __forceinline__ void d_encode(const double* part, int nseams, const float* tol, float* code) {
    if (threadIdx.x != 0 || blockIdx.x != 0) return;
    int k1 = 0, k2 = 0, nact = 0; double e1 = 0.0;
    for (int s = 0; s < nseams; ++s) {
        double num = 0.0, den = 0.0;
        for (int b = 0; b < VIEW_BLOCKS; ++b) { num += part[((long)s * VIEW_BLOCKS + b) * 2]; den += part[((long)s * VIEW_BLOCKS + b) * 2 + 1]; }
        if (!(den > 0.0)) { if (num > 0.0) den = 1e-30; else continue; }
        const double e = num / den; ++nact;
        if (!(e <= (double)tol[s])) { if (k1 == 0) { k1 = s + 1; e1 = e; } else if (k2 == 0) k2 = s + 1; }
    }
    const int mag = (e1 < 1e-3) ? 0 : (e1 < 1e-2) ? 1 : (e1 < 1e-1) ? 2 : 3;
    code[0] = 1.0f + 0.01f * (float)k1;
    code[1] = (k1 == 0) ? (float)nact : (float)(4 * k2 + mag);
}
__global__ void k_apply_code(float* out, const float* code, long n) {
    const float sc = code[0];
    for (long i = (long)blockIdx.x * blockDim.x + threadIdx.x; i < n; i += (long)gridDim.x * blockDim.x) { float v = out[i] * sc; if (i == 0) v += code[1]; out[i] = v; }
}
#endif


extern "C" void kernel_launch(void* const* d_in, const int* in_sizes, int n_in, void* d_out, int out_size, void* d_ws, size_t ws_size, hipStream_t stream) {
    static int inited = 0;
    if (!inited) {
        if (n_in != 27 || (size_t)F_END > ws_size) { fprintf(stderr, "kernel_launch: unexpected n_in %d or workspace %zu < %zu\n", n_in, ws_size, (size_t)F_END); inited = -1; return; }
        if (hipFuncSetAttribute((const void*)mk_fwd, hipFuncAttributeMaxDynamicSharedMemorySize, LDS_BYTES) != hipSuccess) { fprintf(stderr, "kernel_launch: hipFuncSetAttribute failed\n"); inited = -1; return; }
        inited = 1;
    }
    if (inited < 0) return;
    (void)in_sizes; (void)out_size;
    (void)hipMemsetAsync((char*)d_ws + F_CTL, 0, F_CTL_B, stream);
    MKArgs a{};
    for (int i = 0; i < 27; ++i) a.in[i] = (const float*)d_in[i];
    a.out = (float*)d_out; a.ws = (unsigned char*)d_ws; a.ph_lo = 0; a.ph_hi = NPHASE;
    hipLaunchKernelGGL(mk_fwd, dim3(256), dim3(512), LDS_BYTES, stream, a);
}
```
